# Optimizing an MI355X kernel written in HIP

```python
import math
import jax, jax.numpy as jnp
from jax import lax
import numpy as np

D_MODEL = 2048
BATCH = 4
SEQ = 4096
DEPTH = 4

N_A_LAYERS = DEPTH // 2
N_B_LAYERS = DEPTH - N_A_LAYERS
RMS_EPS = 1e-6

E_A = D_MODEL
POOL_WINDOWS = (2, 4, 8, 16)
N_POOL_GROUPS = len(POOL_WINDOWS)
POOL_GROUP_DIM = E_A // N_POOL_GROUPS

HEAD_DIM = 128
HEADS_PER_GROUP = D_MODEL // HEAD_DIM
DILATED_PAIRS = ((128, 1), (512, 4), (2048, 16))
N_DIL_GROUPS = len(DILATED_PAIRS)
E_B = HEADS_PER_GROUP * HEAD_DIM
ROPE_THETA = 10000.0
NEG_INF = -1e30

kernel_name = "yoco_pool_dilated_hybrid"


def rmsnorm(x, g):
    xf = x.astype(jnp.float32)
    inv = lax.rsqrt(jnp.mean(xf * xf, axis=-1, keepdims=True) + RMS_EPS)
    return (xf * inv).astype(x.dtype) * g


def rope_tables(seq):
    inv_freq = 1.0 / (ROPE_THETA ** (jnp.arange(0, HEAD_DIM, 2, dtype=jnp.float32) / HEAD_DIM))
    ang = jnp.arange(seq, dtype=jnp.float32)[:, None] * inv_freq[None, :]
    return jnp.cos(ang), jnp.sin(ang)


def apply_rope(t, cos, sin):
    tf = t.astype(jnp.float32)
    t1, t2 = tf[..., : HEAD_DIM // 2], tf[..., HEAD_DIM // 2:]
    c, s = cos[None, :, None, :], sin[None, :, None, :]
    return jnp.concatenate([t1 * c - t2 * s, t2 * c + t1 * s], axis=-1).astype(t.dtype)


def multiscale_causal_pool(u):
    b, s, _ = u.shape
    u4 = u.reshape(b, s, N_POOL_GROUPS, POOL_GROUP_DIM)
    csum = jnp.cumsum(u4.astype(jnp.float32), axis=1)
    csum = jnp.concatenate([jnp.zeros_like(csum[:, :1]), csum], axis=1)
    win = jnp.asarray(POOL_WINDOWS, dtype=jnp.int32)
    t1 = jnp.arange(1, s + 1, dtype=jnp.int32)[:, None]
    lower = jnp.maximum(t1 - win[None, :], 0)
    c_lo = csum[:, lower, jnp.arange(N_POOL_GROUPS)[None, :], :]
    count = jnp.minimum(t1, win[None, :]).astype(jnp.float32)
    mean = (csum[:, 1:] - c_lo) / count[None, :, :, None]
    return (mean - u4.astype(jnp.float32)).astype(u.dtype)


def dilated_window_attention(q, k, v, window, dilation):
    b, s, h, hd = q.shape
    d = dilation
    nb = window // dilation
    m = s // d
    nblk = -(-m // nb)
    m_pad = nblk * nb

    def residues(t):
        return t.reshape(b, m, d, h, hd).transpose(0, 2, 3, 1, 4)

    qr, kr, vr = residues(q), residues(k), residues(v)
    qb = jnp.pad(qr, ((0, 0), (0, 0), (0, 0), (0, m_pad - m), (0, 0))).reshape(b, d, h, nblk, nb, hd)
    kv_pad = ((0, 0), (0, 0), (0, 0), (nb, m_pad - m), (0, 0))
    kp = jnp.pad(kr, kv_pad).reshape(b, d, h, nblk + 1, nb, hd)
    vp = jnp.pad(vr, kv_pad).reshape(b, d, h, nblk + 1, nb, hd)
    kb = jnp.concatenate([kp[:, :, :, :-1], kp[:, :, :, 1:]], axis=4)
    vb = jnp.concatenate([vp[:, :, :, :-1], vp[:, :, :, 1:]], axis=4)

    scores = jnp.einsum('bdhnqc,bdhnkc->bdhnqk', qb, kb).astype(jnp.float32) * (1.0 / math.sqrt(hd))
    r_idx = jnp.arange(nb)[:, None]
    c_idx = jnp.arange(2 * nb)[None, :]
    band = (c_idx >= r_idx) & (c_idx <= r_idx + nb)
    blk = jnp.arange(nblk)[:, None, None]
    mask = band[None] & (blk * nb + c_idx[None] >= nb)
    scores = jnp.where(mask[None, None, None], scores, NEG_INF)
    lse = jax.nn.logsumexp(scores, axis=-1)
    p = jnp.exp(scores - lse[..., None]).astype(v.dtype)
    out = jnp.einsum('bdhnqk,bdhnkc->bdhnqc', p, vb)

    out = out.reshape(b, d, h, m_pad, hd)[:, :, :, :m]
    lse = lse.reshape(b, d, h, m_pad)[:, :, :, :m]
    out = out.transpose(0, 3, 1, 2, 4).reshape(b, s, h, hd)
    lse = lse.transpose(0, 3, 1, 2).reshape(b, s, h)
    return out, lse


def setup_inputs(seed: int = 0) -> dict:
    key = jax.random.key(seed)
    ks = jax.random.split(key, 13)
    f32 = jnp.float32
    x = jax.random.normal(ks[0], (BATCH, SEQ, D_MODEL), f32)
    norm_a = 1.0 + 0.1 * jax.random.normal(ks[1], (N_A_LAYERS, D_MODEL), f32)
    w_in_a = jax.random.normal(ks[2], (N_A_LAYERS, D_MODEL, 2 * E_A), f32) * D_MODEL ** -0.5
    w_grp_a = jax.random.normal(ks[3], (N_A_LAYERS, N_POOL_GROUPS, POOL_GROUP_DIM, POOL_GROUP_DIM), f32) * POOL_GROUP_DIM ** -0.5
    scale_a = 1.0 + 0.1 * jax.random.normal(ks[4], (N_A_LAYERS, E_A), f32)
    w_out_a = jax.random.normal(ks[5], (N_A_LAYERS, E_A, D_MODEL), f32) * E_A ** -0.5
    norm_kv = 1.0 + 0.1 * jax.random.normal(ks[6], (D_MODEL,), f32)
    w_k = jax.random.normal(ks[7], (D_MODEL, E_B), f32) * D_MODEL ** -0.5
    w_v = jax.random.normal(ks[8], (D_MODEL, E_B), f32) * D_MODEL ** -0.5
    norm_b = 1.0 + 0.1 * jax.random.normal(ks[9], (N_B_LAYERS, D_MODEL), f32)
    w_in_b = jax.random.normal(ks[10], (N_B_LAYERS, D_MODEL, N_DIL_GROUPS * E_B + E_B), f32) * D_MODEL ** -0.5
    w_out_b = jax.random.normal(ks[11], (N_B_LAYERS, E_B, D_MODEL), f32) * E_B ** -0.5
    norm_f = 1.0 + 0.1 * jax.random.normal(ks[12], (D_MODEL,), f32)
    return {"x": x, "norm_a": norm_a, "w_in_a": w_in_a, "w_grp_a": w_grp_a, "scale_a": scale_a,
            "w_out_a": w_out_a, "norm_kv": norm_kv, "w_k": w_k, "w_v": w_v, "norm_b": norm_b,
            "w_in_b": w_in_b, "w_out_b": w_out_b, "norm_f": norm_f}


def reference(x, norm_a, w_in_a, w_grp_a, scale_a, w_out_a, norm_kv, w_k, w_v, norm_b, w_in_b, w_out_b, norm_f):
    b, s, _ = x.shape
    cos, sin = rope_tables(s)
    k_shared = None
    v_shared = None
    for layer in range(DEPTH):
        if layer < N_A_LAYERS:
            i = layer
            hdn = rmsnorm(x, norm_a[i])
            proj = hdn @ w_in_a[i]
            u, gate = proj[..., :E_A], proj[..., E_A:]
            pooled = multiscale_causal_pool(u)
            y = jnp.einsum('bsgc,gcd->bsgd', pooled, w_grp_a[i]).reshape(b, s, E_A) * scale_a[i]
            x = x + (y * jax.nn.silu(gate)) @ w_out_a[i]
            if layer == N_A_LAYERS - 1:
                kv_in = rmsnorm(x, norm_kv)
                k_shared = apply_rope((kv_in @ w_k).reshape(b, s, HEADS_PER_GROUP, HEAD_DIM), cos, sin)
                v_shared = (kv_in @ w_v).reshape(b, s, HEADS_PER_GROUP, HEAD_DIM)
        else:
            i = layer - N_A_LAYERS
            hdn = rmsnorm(x, norm_b[i])
            proj = hdn @ w_in_b[i]
            q_all = proj[..., : N_DIL_GROUPS * E_B].reshape(b, s, N_DIL_GROUPS, HEADS_PER_GROUP, HEAD_DIM)
            gate = proj[..., N_DIL_GROUPS * E_B:]
            outs = []
            lses = []
            for g, (window, dilation) in enumerate(DILATED_PAIRS):
                q = apply_rope(q_all[:, :, g], cos, sin)
                o_g, lse_g = dilated_window_attention(q, k_shared, v_shared, window, dilation)
                outs.append(o_g)
                lses.append(lse_g)
            alpha = jax.nn.softmax(jnp.stack(lses, axis=0), axis=0)
            merged = jnp.sum(alpha[..., None].astype(x.dtype) * jnp.stack(outs, axis=0), axis=0)
            merged = merged.reshape(b, s, E_B)
            x = x + (merged * jax.nn.silu(gate)) @ w_out_b[i]
    return rmsnorm(x, norm_f)
```

```cpp
#include <hip/hip_runtime.h>
#include <hip/hip_cooperative_groups.h>
#include <cstdio>
#include <cstdint>
namespace cg = cooperative_groups;
namespace pg8 {
#define PG8_LAS __attribute__((address_space(3)))
typedef unsigned short bf16_t;
typedef short bf16x8 __attribute__((ext_vector_type(8)));
typedef float f32x4 __attribute__((ext_vector_type(4)));
typedef unsigned u32x4 __attribute__((ext_vector_type(4)));
constexpr int BM = 256, BK = 64, HALF = 128, HTB = HALF * BK * 2  , STAGE_BYTES = 8 * HTB, NXCD = 8, WGM = 8;

__host__ __device__ __forceinline__ int lds_byte(int r, int c) { const int st = (r >> 4) * 2 + (c >> 5), rr = r & 15, cc = c & 31, ob = rr * 64 + cc * 2; return st * 1024 + (ob ^ (((ob >> 9) & 1) << 5)); }
__host__ __device__ __forceinline__ void stage_rc(int b, int& R, int& C) { const int st = b / 1024, sb = b % 1024, swz = sb ^ (((sb >> 9) & 1) << 5); R = (st >> 1) * 16 + swz / 64; C = (st & 1) * 32 + (swz % 64) / 2; }
__host__ __device__ __forceinline__ int perm32(int rho) { const int n = rho >> 4, i = rho & 15; return 8 * (i >> 2) + 4 * n + (i & 3); }

struct Unit { int pm, pn; };
struct Gemm { const bf16_t* A; const bf16_t* Bt; int M, N, K, lda, agrp, ldb, bmode; };

struct StaticOrder {
    int nM, nN, nwg, G, c;
    __host__ __device__ void init(int M, int N, int G_, int c_) { nM = M / BM; nN = N / BM; nwg = nM * nN; G = G_; c = c_; }
    __host__ __device__ bool next(int i, Unit& u) const {
        const long L = (long)i * G + c; if (L >= nwg) return false;
        int wgid = (int)L; { const int q = nwg / NXCD, r = nwg % NXCD, xcd = wgid % NXCD, off = wgid / NXCD; wgid = (xcd < r ? xcd * (q + 1) : r * (q + 1) + (xcd - r) * q) + off; }
        const int nig = WGM * nN, gid = wgid / nig, fm = gid * WGM, gsz = (nM - fm) < WGM ? (nM - fm) : WGM;
        u.pm = fm + ((wgid % nig) % gsz); u.pn = (wgid % nig) / gsz; return true;
    }
    __device__ __forceinline__ void a_ready(const Unit&) const {}
    __device__ __forceinline__ void done(const Unit&) const {}
};

struct HalfOrder : StaticOrder { int pmoff;
    __host__ __device__ bool next(int i, Unit& u) const { const bool r = StaticOrder::next(i, u); u.pm += pmoff; return r; } };
__device__ __forceinline__ unsigned cvt_pk_bf16(float lo, float hi) { unsigned r; asm volatile("v_cvt_pk_bf16_f32 %0, %1, %2" : "=v"(r) : "v"(lo), "v"(hi)); return r; }
typedef float f32x2 __attribute__((ext_vector_type(2)));
template <class Epi, class Sched, bool ALIGN_EPI = false, bool SP2 = false>
__device__ __forceinline__ void gemm_phase(PG8_LAS unsigned char* lds, const Gemm g, const Sched& S, const Epi& E) {
    int tid_ = threadIdx.x; asm volatile("" : "+v"(tid_));
    const int tid = tid_, wid = __builtin_amdgcn_readfirstlane(tid >> 6), lane = tid & 63, wr = wid >> 2, wc = wid & 3, fr = lane & 15, fq = lane >> 4;
    const int K = g.K, nt = K / BK;
    unsigned voffA[2], voffB[2];
#pragma unroll
    for (int i = 0; i < 2; ++i) { int R, C; stage_rc(tid * 16 + i * 8192, R, C); const int Rb = Epi::PERM ? ((R & ~31) + perm32(R & 31)) : R;
        voffA[i] = (unsigned)(R * g.lda + C) * 2u; voffB[i] = (unsigned)(Rb * g.ldb + C) * 2u; }
    const size_t kstep = (size_t)(BK * 2);
    const size_t hstep = (size_t)HALF * g.ldb * 2;
    const size_t tstep = 2 * hstep;
    const size_t hstepA = (size_t)HALF * g.lda * 2, tstepA = 2 * hstepA;
    const unsigned ldsw = (unsigned)wid * 1024u;
    const int aoff = lds_byte(wr * 64 + fr, fq * 8), boff = lds_byte(wc * 32 + fr, fq * 8);
#define PG8_SA(b, h) (((b) * 2 + (h)) * HTB)
#define PG8_SB(b, h) ((4 + (b) * 2 + (h)) * HTB)
#define PG8_STAGE(bufoff, gbase, voff) do { _Pragma("unroll") for (int _i = 0; _i < 2; ++_i) \
        __builtin_amdgcn_global_load_lds((const unsigned*)((const char*)(gbase) + (voff)[_i]), (PG8_LAS unsigned*)(lds + (bufoff) + ldsw + _i * 8192), 16, 0, 0); } while (0)
#define PG8_LDA(dst, b, h) do { _Pragma("unroll") for (int m = 0; m < 4; ++m) _Pragma("unroll") for (int k = 0; k < 2; ++k) dst[m][k] = *(const PG8_LAS bf16x8*)(lds + PG8_SA(b, h) + aoff + m * 2048 + k * 1024); } while (0)
#define PG8_LDB(dst, b, h) do { _Pragma("unroll") for (int n = 0; n < 2; ++n) _Pragma("unroll") for (int k = 0; k < 2; ++k) dst[n][k] = *(const PG8_LAS bf16x8*)(lds + PG8_SB(b, h) + boff + n * 2048 + k * 1024); } while (0)
#define PG8_MMA(ai, bj, At, Bt) do { __builtin_amdgcn_s_setprio(1); _Pragma("unroll") for (int m = 0; m < 4; ++m) _Pragma("unroll") for (int n = 0; n < 2; ++n) _Pragma("unroll") for (int k = 0; k < 2; ++k) \
        acc[ai][bj][m][n] = __builtin_amdgcn_mfma_f32_16x16x32_bf16(Bt[n][k], At[m][k], acc[ai][bj][m][n], 0, 0, 0); __builtin_amdgcn_s_setprio(0); } while (0)
#define PG8_WAIT_V(n) asm volatile("s_waitcnt vmcnt(" #n ")" ::: "memory")
#define PG8_WAIT_L(n) asm volatile("s_waitcnt lgkmcnt(" #n ")" ::: "memory")
#define PG8_BAR __builtin_amdgcn_s_barrier()
#define PG8_SCHED __builtin_amdgcn_sched_barrier(0)
    Unit cur, nxt; int ui = 0;
    if (!S.next(0, cur)) return;
    f32x4 acc[2][2][4][2];
#pragma unroll
    for (int a = 0; a < 2; ++a)
#pragma unroll
        for (int b = 0; b < 2; ++b)
#pragma unroll
            for (int m = 0; m < 4; ++m)
#pragma unroll
                for (int n = 0; n < 2; ++n) acc[a][b][m][n] = (f32x4){0.f, 0.f, 0.f, 0.f};
    bf16x8 At[4][2], B0[2][2], B1[2][2];
    const char* cA = (const char*)g.A + (size_t)cur.pm * tstepA + (size_t)((cur.pn >> 1) * g.agrp) * 2; const char* cB = (const char*)g.Bt + (size_t)cur.pn * tstep + (g.bmode ? ((size_t)(cur.pm >> 3) * 2048 * 2048 + (size_t)((cur.pm >> 1) & 3) * 512) * 2 : (size_t)0);
    S.a_ready(cur);
    if constexpr (SP2) {
        PG8_STAGE(PG8_SB(0, 0), cB, voffB); PG8_STAGE(PG8_SB(0, 1), cB + hstep, voffB); PG8_STAGE(PG8_SA(0, 0), cA, voffA); PG8_STAGE(PG8_SA(0, 1), cA + hstepA, voffA);
        if (wr == 1) PG8_BAR;
        PG8_WAIT_V(2); PG8_BAR;
        PG8_STAGE(PG8_SB(1, 0), cB + kstep, voffB); PG8_STAGE(PG8_SA(1, 0), cA + kstep, voffA); PG8_STAGE(PG8_SB(1, 1), cB + hstep + kstep, voffB);
        PG8_WAIT_V(6); PG8_BAR;
    } else {
        PG8_STAGE(PG8_SB(0, 0), cB, voffB); PG8_STAGE(PG8_SA(0, 0), cA, voffA); PG8_STAGE(PG8_SB(0, 1), cB + hstep, voffB); PG8_STAGE(PG8_SA(0, 1), cA + hstepA, voffA);
        if (wr == 1) PG8_BAR;
        PG8_WAIT_V(4); PG8_BAR;
        PG8_STAGE(PG8_SB(1, 0), cB + kstep, voffB); PG8_STAGE(PG8_SA(1, 0), cA + kstep, voffA); PG8_STAGE(PG8_SB(1, 1), cB + hstep + kstep, voffB);
        PG8_WAIT_V(6); PG8_BAR;
    }
    for (;;) {
        const bool has_next = S.next(ui + 1, nxt);
        const char* nA = has_next ? (const char*)g.A + (size_t)nxt.pm * tstepA + (size_t)((nxt.pn >> 1) * g.agrp) * 2 : cA; const char* nB = has_next ? (const char*)g.Bt + (size_t)nxt.pn * tstep + (g.bmode ? ((size_t)(nxt.pm >> 3) * 2048 * 2048 + (size_t)((nxt.pm >> 1) & 3) * 512) * 2 : (size_t)0) : cB;
        for (int t = 0; t < nt; t += 2) {
            const bool last = (t == nt - 2);
            const char* a1 = cA + (size_t)(t + 1) * kstep;
            const char* a2 = last ? nA : cA + (size_t)(t + 2) * kstep; const char* b2 = last ? nB : cB + (size_t)(t + 2) * kstep;
            const char* a3 = a2 + kstep; const char* b3 = b2 + kstep;
            if (last && has_next) S.a_ready(nxt);
            if constexpr (SP2) {
            PG8_LDB(B0, 0, 0); PG8_LDB(B1, 0, 1); PG8_SCHED; PG8_LDA(At, 0, 0); PG8_STAGE(PG8_SA(1, 1), a1 + hstepA, voffA);
            PG8_WAIT_V(8); PG8_WAIT_L(0); PG8_BAR; PG8_MMA(0, 0, At, B0); PG8_MMA(0, 1, At, B1); PG8_BAR; PG8_SCHED;
            PG8_LDA(At, 0, 1); PG8_STAGE(PG8_SB(0, 0), b2, voffB); PG8_STAGE(PG8_SB(0, 1), b2 + hstep, voffB); PG8_STAGE(PG8_SA(0, 0), a2, voffA);
            PG8_WAIT_V(8); PG8_WAIT_L(0); PG8_BAR; PG8_MMA(1, 0, At, B0); PG8_MMA(1, 1, At, B1); PG8_BAR; PG8_SCHED;
            PG8_LDB(B0, 1, 0); PG8_LDB(B1, 1, 1); PG8_SCHED; PG8_LDA(At, 1, 0); PG8_STAGE(PG8_SA(0, 1), a2 + hstepA, voffA);
            PG8_WAIT_V(8); PG8_WAIT_L(0); PG8_BAR; PG8_MMA(0, 0, At, B0); PG8_MMA(0, 1, At, B1); PG8_BAR; PG8_SCHED;
            PG8_LDA(At, 1, 1); PG8_STAGE(PG8_SB(1, 0), b3, voffB); PG8_STAGE(PG8_SB(1, 1), b3 + hstep, voffB); PG8_STAGE(PG8_SA(1, 0), a3, voffA);
            PG8_WAIT_V(8); PG8_WAIT_L(0); PG8_BAR; PG8_MMA(1, 0, At, B0); PG8_MMA(1, 1, At, B1); PG8_BAR; PG8_SCHED;
            } else {
            PG8_LDB(B0, 0, 0); PG8_SCHED; PG8_LDA(At, 0, 0); PG8_STAGE(PG8_SA(1, 1), a1 + hstepA, voffA);
            PG8_WAIT_L(8); PG8_BAR; PG8_WAIT_L(0); PG8_MMA(0, 0, At, B0); PG8_BAR; PG8_SCHED;
            PG8_LDB(B1, 0, 1); PG8_STAGE(PG8_SB(0, 0), b2, voffB);
            PG8_BAR; PG8_WAIT_L(0); PG8_MMA(0, 1, At, B1); PG8_BAR;
            PG8_LDA(At, 0, 1); PG8_STAGE(PG8_SA(0, 0), a2, voffA);
            PG8_BAR; PG8_WAIT_L(0); PG8_MMA(1, 0, At, B0); PG8_BAR; PG8_SCHED;
            PG8_STAGE(PG8_SB(0, 1), b2 + hstep, voffB);
            PG8_WAIT_V(6); PG8_BAR; PG8_MMA(1, 1, At, B1); PG8_BAR;
            PG8_LDB(B0, 1, 0); PG8_SCHED; PG8_LDA(At, 1, 0); PG8_STAGE(PG8_SA(0, 1), a2 + hstepA, voffA);
            PG8_WAIT_L(8); PG8_BAR; PG8_WAIT_L(0); PG8_MMA(0, 0, At, B0); PG8_BAR; PG8_SCHED;
            PG8_LDB(B1, 1, 1); PG8_STAGE(PG8_SB(1, 0), b3, voffB);
            PG8_BAR; PG8_WAIT_L(0); PG8_MMA(0, 1, At, B1); PG8_BAR;
            PG8_LDA(At, 1, 1); PG8_STAGE(PG8_SA(1, 0), a3, voffA);
            PG8_BAR; PG8_WAIT_L(0); PG8_MMA(1, 0, At, B0); PG8_BAR; PG8_SCHED;
            PG8_STAGE(PG8_SB(1, 1), b3 + hstep, voffB);
            PG8_WAIT_V(6); PG8_BAR; PG8_MMA(1, 1, At, B1); PG8_BAR;
            }
        }
        if constexpr (ALIGN_EPI) { if (wr == 0) PG8_BAR; }
        if constexpr (!Epi::AFTER_DRAIN) { E(acc, cur, wr, wc, fr, fq); S.done(cur); }
        if (!has_next) break;
#pragma unroll
        for (int a = 0; a < 2; ++a)
#pragma unroll
            for (int b = 0; b < 2; ++b)
#pragma unroll
                for (int m = 0; m < 4; ++m)
#pragma unroll
                    for (int n = 0; n < 2; ++n) acc[a][b][m][n] = (f32x4){0.f, 0.f, 0.f, 0.f};
        cur = nxt; cA = nA; cB = nB; ++ui;
        if constexpr (ALIGN_EPI) { if (wr == 1) PG8_BAR; }
    }
    PG8_WAIT_V(0);
    if constexpr (!ALIGN_EPI) { if (wr == 0) PG8_BAR; }
    PG8_BAR;
    if constexpr (Epi::AFTER_DRAIN) { E.fused(acc, cur, wr, wc, fr, fq, lds, wid, lane); S.done(cur); }
#undef PG8_SA
#undef PG8_SB
#undef PG8_STAGE
#undef PG8_LDA
#undef PG8_LDB
#undef PG8_MMA
#undef PG8_WAIT_V
#undef PG8_WAIT_L
#undef PG8_BAR
#undef PG8_SCHED
}
}
#define LAS __attribute__((address_space(3)))
#define GAS __attribute__((address_space(1)))
using pg8::bf16_t; using pg8::bf16x8; using pg8::f32x4; using pg8::u32x4; using pg8::cvt_pk_bf16; using pg8::Unit; using pg8::HALF;
typedef short s16x4 __attribute__((ext_vector_type(4)));
typedef unsigned u32x2 __attribute__((ext_vector_type(2)));
constexpr int T = 16384, D = 2048, SEQ = 4096, NH = 16;
constexpr float RMS_EPS = 1e-6f;
constexpr float QSCALE = 0.12751743082459868f;
constexpr size_t MiB = 1u << 20;
constexpr size_t WS_SLOTA = 0, WS_WOUTB0 = 48 * MiB, WS_SCR = 56 * MiB, WS_BUF0 = 64 * MiB, WS_BUF1 = 128 * MiB, WS_K = 192 * MiB, WS_V = 256 * MiB, WS_Q = 320 * MiB;
constexpr size_t WS_END = 512 * MiB;
constexpr size_t WS_WA = 0;
constexpr size_t WS_SSQ = WS_SCR, WS_LSE = WS_SCR + 1 * MiB, WS_COS = WS_SCR + 3 * MiB, WS_SIN = WS_SCR + 4 * MiB;
constexpr size_t WS_WINA0 = WS_WA, WS_WINA1 = WS_WA + 16 * MiB, WS_WG0 = WS_WA + 32 * MiB, WS_WG1 = WS_WA + 34 * MiB, WS_WOUTA0 = WS_WA + 36 * MiB, WS_WOUTA1 = WS_WA + 44 * MiB;
constexpr size_t OUT_WINB1 = 64 * MiB, OUT_WOUTB1 = 96 * MiB;
constexpr size_t WS_WU = 440 * MiB;
constexpr int LDS_BYTES = 147456, LDS_BARST = 143360;
constexpr size_t WS_FLAGS = WS_SCR + 512 * 1024 + 3 * 16384;
constexpr size_t WS_BAR = WS_SCR + 512 * 1024;
constexpr int AT_KP = 272, AT_VP = 288, AT_VOFF = 256 * AT_KP;
static_assert(AT_VOFF + 256 * AT_VP <= 143360, "attention LDS");

__device__ __forceinline__ int tid_l() { int t = threadIdx.x; asm volatile("" : "+v"(t)); return t; }
__device__ __forceinline__ float bf_lo(unsigned w) { return __uint_as_float(w << 16); }
__device__ __forceinline__ float bf_hi(unsigned w) { return __uint_as_float(w & 0xffff0000u); }
__device__ __forceinline__ float silu_f(float v) { return v * __builtin_amdgcn_rcpf(1.0f + __builtin_amdgcn_exp2f(-1.44269504089f * v)); }

struct EpiInA {
    static constexpr bool PERM = true, AFTER_DRAIN = false;
    const float* ssq; bf16_t* u; bf16_t* sg;
    __device__ __forceinline__ void operator()(const f32x4 (&acc)[2][2][4][2], const Unit& un, int wr, int wc, int fr, int fq) const {
        const int row0 = un.pm * 256 + wr * 64 + fr; const bool gate = un.pn >= 8;
        bf16_t* base = gate ? sg : u; const int col0 = (un.pn & 7) * 256 + wc * 32 + 8 * fq;
        float inv[2][4];
#pragma unroll
        for (int ai = 0; ai < 2; ++ai)
#pragma unroll
            for (int m = 0; m < 4; ++m) inv[ai][m] = ssq[row0 + ai * HALF + m * 16];
#pragma unroll
        for (int ai = 0; ai < 2; ++ai)
#pragma unroll
            for (int m = 0; m < 4; ++m) inv[ai][m] = rsqrtf(inv[ai][m] * (1.0f / D) + RMS_EPS);
#pragma unroll
        for (int ai = 0; ai < 2; ++ai)
#pragma unroll
            for (int m = 0; m < 4; ++m) { const int row = row0 + ai * HALF + m * 16; const float iv = inv[ai][m];
                bf16_t* rowp = base + (size_t)row * D + col0;
#pragma unroll
                for (int bj = 0; bj < 2; ++bj) { f32x4 v0 = acc[ai][bj][m][0] * iv, v1 = acc[ai][bj][m][1] * iv;
                    if (gate) {
#pragma unroll
                        for (int j = 0; j < 4; ++j) { v0[j] = silu_f(v0[j]); v1[j] = silu_f(v1[j]); } }
                    u32x4 w; w.x = cvt_pk_bf16(v0[0], v0[1]); w.y = cvt_pk_bf16(v0[2], v0[3]); w.z = cvt_pk_bf16(v1[0], v1[1]); w.w = cvt_pk_bf16(v1[2], v1[3]);
                    *(u32x4*)(rowp + bj * HALF) = w; } }
    }
};
struct EpiFold {
    static constexpr bool PERM = true, AFTER_DRAIN = false;
    bf16_t* W0; size_t layer_stride;
    __device__ __forceinline__ void operator()(const f32x4 (&acc)[2][2][4][2], const Unit& un, int wr, int wc, int fr, int fq) const {
        const int row0 = (un.pm & 7) * 256 + wr * 64 + fr; const int col0 = un.pn * 256 + wc * 32 + 8 * fq; bf16_t* base = W0 + (size_t)(un.pm >> 3) * layer_stride;
#pragma unroll
        for (int ai = 0; ai < 2; ++ai)
#pragma unroll
            for (int m = 0; m < 4; ++m) { bf16_t* rowp = base + (size_t)(row0 + ai * HALF + m * 16) * D + col0;
#pragma unroll
                for (int bj = 0; bj < 2; ++bj) { const f32x4 v0 = acc[ai][bj][m][0], v1 = acc[ai][bj][m][1];
                    u32x4 w; w.x = cvt_pk_bf16(v0[0], v0[1]); w.y = cvt_pk_bf16(v0[2], v0[3]); w.z = cvt_pk_bf16(v1[0], v1[1]); w.w = cvt_pk_bf16(v1[2], v1[3]);
                    *(u32x4*)(rowp + bj * HALF) = w; } }
    }
};
struct EpiOut {
    static constexpr bool PERM = true, AFTER_DRAIN = false;
    const bf16_t* xin; bf16_t* xout; float* ssq_next;
    __device__ __forceinline__ void operator()(const f32x4 (&acc)[2][2][4][2], const Unit& un, int wr, int wc, int fr, int fq) const {
        const int row0 = un.pm * 256 + wr * 64 + fr; const int col0 = un.pn * 256 + wc * 32 + 8 * fq;
#pragma unroll
        for (int ai = 0; ai < 2; ++ai) { u32x4 xv[4][2];
#pragma unroll
            for (int m = 0; m < 4; ++m)
#pragma unroll
                for (int bj = 0; bj < 2; ++bj) xv[m][bj] = *(const u32x4*)(xin + (size_t)(row0 + ai * HALF + m * 16) * D + col0 + bj * HALF);
            __builtin_amdgcn_sched_barrier(0);
#pragma unroll
            for (int m = 0; m < 4; ++m) { const int row = row0 + ai * HALF + m * 16; const size_t off = (size_t)row * D + col0; float ss = 0.f;
#pragma unroll
                for (int bj = 0; bj < 2; ++bj) { const u32x4 x = xv[m][bj];
                    f32x4 a = acc[ai][bj][m][0], b = acc[ai][bj][m][1];
                    a[0] += bf_lo(x.x); a[1] += bf_hi(x.x); a[2] += bf_lo(x.y); a[3] += bf_hi(x.y); b[0] += bf_lo(x.z); b[1] += bf_hi(x.z); b[2] += bf_lo(x.w); b[3] += bf_hi(x.w);
                    ss += (a[0] * a[0] + a[1] * a[1]) + (a[2] * a[2] + a[3] * a[3]) + (b[0] * b[0] + b[1] * b[1]) + (b[2] * b[2] + b[3] * b[3]);
                    u32x4 w; w.x = cvt_pk_bf16(a[0], a[1]); w.y = cvt_pk_bf16(a[2], a[3]); w.z = cvt_pk_bf16(b[0], b[1]); w.w = cvt_pk_bf16(b[2], b[3]);
                    *(u32x4*)(xout + off + bj * HALF) = w; }
                ss += __shfl_xor(ss, 16); ss += __shfl_xor(ss, 32);
                if (fq == 0) atomicAdd(ssq_next + row, ss); }
            __builtin_amdgcn_sched_barrier(0); }
    }
};
struct EpiInB {
    static constexpr bool PERM = true, AFTER_DRAIN = false;
    const float* ssq; const float* cosT; const float* sinT; bf16_t* Kb; bf16_t* Vb; bf16_t* Qb; bf16_t* sg; int kvt;
    __device__ __forceinline__ void operator()(const f32x4 (&acc)[2][2][4][2], const Unit& un, int wr, int wc, int fr, int fq) const {
        const int row0 = un.pm * 256 + wr * 64 + fr; int pn = un.pn; const int j0 = wc * 32 + 8 * fq; const int bb = un.pm >> 4;
        int kind;  bf16_t* base; float osc = 1.f; int head0;
        if (pn < kvt) { if (pn < 8) { kind = 0; base = Kb + (size_t)bb * NH * SEQ * 128; head0 = 2 * pn; } else { kind = 1; base = Vb + (size_t)bb * NH * SEQ * 128; head0 = 2 * (pn - 8); } }
        else { pn -= kvt; if (pn < 24) { kind = 0; const int g = pn >> 3; base = Qb + (size_t)(g * 4 + bb) * NH * SEQ * 128; head0 = 2 * (pn & 7); osc = QSCALE; } else { kind = 2; base = sg; head0 = 0; pn -= 24; } }
        float inv[2][4];
#pragma unroll
        for (int ai = 0; ai < 2; ++ai)
#pragma unroll
            for (int m = 0; m < 4; ++m) inv[ai][m] = ssq[row0 + ai * HALF + m * 16];
        if (kind == 0) {
            const int f0 = j0 & 63; bf16_t* hb = base + (size_t)(head0 + (j0 >> 6)) * SEQ * 128 + f0;
            f32x4 cs[2][4];
#define EPI_LDCS(buf, gi) do { const int s_ = (row0 + ((gi) >> 2) * HALF + ((gi) & 3) * 16) & (SEQ - 1); const float* cp_ = cosT + s_ * 64 + f0; const float* sp_ = sinT + s_ * 64 + f0; \
                cs[buf][0] = *(const f32x4*)cp_; cs[buf][1] = *(const f32x4*)(cp_ + 4); cs[buf][2] = *(const f32x4*)sp_; cs[buf][3] = *(const f32x4*)(sp_ + 4); } while (0)
            EPI_LDCS(0, 0);
#pragma unroll
            for (int gi = 0; gi < 8; ++gi) { const int ai = gi >> 2, m = gi & 3;
                if (gi + 1 < 8) EPI_LDCS((gi + 1) & 1, gi + 1);
                const int row = row0 + ai * HALF + m * 16; const float iv = rsqrtf(inv[ai][m] * (1.0f / D) + RMS_EPS) * osc; const int s = row & (SEQ - 1);
                u32x4 w1, w2;
#pragma unroll
                for (int n = 0; n < 2; ++n) { const f32x4 c = cs[gi & 1][n], sn = cs[gi & 1][2 + n];
                    const f32x4 x1 = acc[ai][0][m][n] * iv, x2 = acc[ai][1][m][n] * iv;
                    const f32x4 o1 = x1 * c - x2 * sn, o2 = x2 * c + x1 * sn;
                    if (n == 0) { w1.x = cvt_pk_bf16(o1[0], o1[1]); w1.y = cvt_pk_bf16(o1[2], o1[3]); w2.x = cvt_pk_bf16(o2[0], o2[1]); w2.y = cvt_pk_bf16(o2[2], o2[3]); }
                    else        { w1.z = cvt_pk_bf16(o1[0], o1[1]); w1.w = cvt_pk_bf16(o1[2], o1[3]); w2.z = cvt_pk_bf16(o2[0], o2[1]); w2.w = cvt_pk_bf16(o2[2], o2[3]); } }
                bf16_t* rowp = hb + (size_t)s * 128;
                *(u32x4*)rowp = w1; *(u32x4*)(rowp + 64) = w2; }
#undef EPI_LDCS
        } else if (kind == 1) {
#pragma unroll
            for (int ai = 0; ai < 2; ++ai)
#pragma unroll
                for (int m = 0; m < 4; ++m) { const int row = row0 + ai * HALF + m * 16; const float iv = rsqrtf(inv[ai][m] * (1.0f / D) + RMS_EPS); const int s = row & (SEQ - 1);
#pragma unroll
                    for (int bj = 0; bj < 2; ++bj) { const f32x4 v0 = acc[ai][bj][m][0] * iv, v1 = acc[ai][bj][m][1] * iv;
                        u32x4 w; w.x = cvt_pk_bf16(v0[0], v0[1]); w.y = cvt_pk_bf16(v0[2], v0[3]); w.z = cvt_pk_bf16(v1[0], v1[1]); w.w = cvt_pk_bf16(v1[2], v1[3]);
                        *(u32x4*)(base + ((size_t)(head0 + bj) * SEQ + s) * 128 + j0) = w; } }
        } else {
            const int col0 = pn * 256 + j0;
#pragma unroll
            for (int ai = 0; ai < 2; ++ai)
#pragma unroll
                for (int m = 0; m < 4; ++m) { const int row = row0 + ai * HALF + m * 16; const float iv = rsqrtf(inv[ai][m] * (1.0f / D) + RMS_EPS);
                    bf16_t* rowp = base + (size_t)row * D + col0;
#pragma unroll
                    for (int bj = 0; bj < 2; ++bj) { f32x4 v0 = acc[ai][bj][m][0] * iv, v1 = acc[ai][bj][m][1] * iv;
#pragma unroll
                        for (int j = 0; j < 4; ++j) { v0[j] = silu_f(v0[j]); v1[j] = silu_f(v1[j]); }
                        u32x4 w; w.x = cvt_pk_bf16(v0[0], v0[1]); w.y = cvt_pk_bf16(v0[2], v0[3]); w.z = cvt_pk_bf16(v1[0], v1[1]); w.w = cvt_pk_bf16(v1[2], v1[3]);
                        *(u32x4*)(rowp + bj * HALF) = w; } }
        }
    }
};
__device__ __forceinline__ void transpose_item(const float* W, int ldw, int scol0, const float* gvec, bf16_t* WT, int K, int drow0, LAS float* scr, int k0, int lane) {
    float tv[32]; const float* wp = W + (size_t)(k0 + (lane >> 5)) * ldw + scol0 + (lane & 31);
#pragma unroll
    for (int i = 0; i < 32; ++i) tv[i] = __builtin_nontemporal_load(wp + (size_t)(2 * i) * ldw);
    if (gvec) { const float* gp = gvec + k0 + (lane >> 5);
#pragma unroll
        for (int i = 0; i < 32; ++i) tv[i] *= gp[2 * i]; }
#pragma unroll
    for (int i = 0; i < 32; ++i) scr[(2 * i + (lane >> 5)) * 33 + (lane & 31)] = tv[i];
    asm volatile("s_waitcnt lgkmcnt(0)" ::: "memory");
    const int c = lane & 7;
#pragma unroll
    for (int j = 0; j < 4; ++j) { const int n = (lane >> 3) + 8 * j; const LAS float* s = scr + (8 * c) * 33 + n;
        u32x4 o; o.x = cvt_pk_bf16(s[0 * 33], s[1 * 33]); o.y = cvt_pk_bf16(s[2 * 33], s[3 * 33]); o.z = cvt_pk_bf16(s[4 * 33], s[5 * 33]); o.w = cvt_pk_bf16(s[6 * 33], s[7 * 33]);
        *(u32x4*)(WT + (size_t)(drow0 + n) * K + k0 + 8 * c) = o; }
    asm volatile("s_waitcnt lgkmcnt(0)" ::: "memory");
}
__device__ __forceinline__ void convert_job(const float* W, int ldw, int scol_base, int K, int N, const float* gvec, bf16_t* WT, bool perm, int gw, int NGW, LAS float* scr, int lane) {
    const int nblk = N / 32, items = (K / 64) * nblk;
    for (int it = gw; it < items; it += NGW) { const int kb = it / nblk, nb = it % nblk; const int n0 = 32 * nb; int sc = n0;
        if (perm) { const int t = n0 & 255, blk = t >> 6; sc = (n0 & ~255) + (blk == 1 ? t + 64 : (blk == 2 ? t - 64 : t)); }
        transpose_item(W, ldw, scol_base + sc, gvec, WT, K, n0, scr, 64 * kb, lane); }
}

struct Params { const float* in[13]; float* out; unsigned char* ws; int ph_lo, ph_hi; };

__device__ __forceinline__ void prologue(const Params& p, LAS unsigned char* lds, int vcu, int G) {
    const int tid = tid_l(), lane = tid & 63, wave = tid >> 6; unsigned char* ws = p.ws; unsigned char* ow = (unsigned char*)p.out;
    LAS float* scr = (LAS float*)(lds + wave * 16384);
    const int gw = vcu * 8 + wave, NGW = G * 8;
    const float* norm_a = p.in[1]; const float* w_in_a = p.in[2]; const float* w_grp_a = p.in[3]; const float* w_out_a = p.in[5];
    { const float* x = p.in[0]; bf16_t* xb = (bf16_t*)(ws + WS_BUF0); float* ssq = (float*)(ws + WS_SSQ);
      for (int row = gw; row < T; row += NGW) { const f32x4* xr = (const f32x4*)(x + (size_t)row * D) + lane; float s = 0.f; u32x2* o = (u32x2*)(xb + (size_t)row * D) + lane;
#pragma unroll
          for (int j = 0; j < 8; ++j) { const f32x4 v = __builtin_nontemporal_load(xr + 64 * j); s += (v[0] * v[0] + v[1] * v[1]) + (v[2] * v[2] + v[3] * v[3]); u32x2 w; w.x = cvt_pk_bf16(v[0], v[1]); w.y = cvt_pk_bf16(v[2], v[3]); o[64 * j] = w; }
#pragma unroll
          for (int o2 = 1; o2 < 64; o2 <<= 1) s += __shfl_xor(s, o2);
          if (lane == 0) ssq[row] = s; }
      for (int i = (vcu * 512 + tid); i < 4 * T; i += G * 512) ssq[T + i] = 0.f;
    }
    { float* cosT = (float*)(ws + WS_COS); float* sinT = (float*)(ws + WS_SIN);
      for (int i = (vcu * 512 + tid); i < SEQ * 64; i += G * 512) { const int s = i >> 6, f = i & 63;
          const float inv_freq = (float)exp2(-(double)f * (13.287712379549449 / 64.0));
          const float ang = (float)s * inv_freq; double t = (double)ang * 0.15915494309189535; t -= floor(t); const float tf = (float)t;
          cosT[i] = __builtin_amdgcn_cosf(tf); sinT[i] = __builtin_amdgcn_sinf(tf); } }
    for (int i = 0; i < 2; ++i) {
        convert_job(w_in_a + (size_t)i * D * 2 * D, 2 * D, D, D, D, norm_a + i * D, (bf16_t*)(ow + (i ? WS_WINA1 : WS_WINA0)) + (size_t)D * D, false, gw, NGW, scr, lane);
        { const float* wsrc = w_in_a + (size_t)i * D * 2 * D; const float* gv = norm_a + i * D; bf16_t* wu = (bf16_t*)(ws + WS_WU) + (size_t)i * D * D;
          for (int it = vcu * 512 + tid; it < D * D / 8; it += G * 512) { const int k = it >> 8, c8 = (it & 255) * 8; const float gk = gv[k];
              const f32x4 a = __builtin_nontemporal_load((const f32x4*)(wsrc + (size_t)k * 2 * D + c8)) * gk, b = __builtin_nontemporal_load((const f32x4*)(wsrc + (size_t)k * 2 * D + c8 + 4)) * gk;
              u32x4 w; w.x = cvt_pk_bf16(a[0], a[1]); w.y = cvt_pk_bf16(a[2], a[3]); w.z = cvt_pk_bf16(b[0], b[1]); w.w = cvt_pk_bf16(b[2], b[3]);
              *(u32x4*)(wu + (size_t)k * D + c8) = w; } }
        convert_job(w_out_a + (size_t)i * D * D, D, 0, D, D, nullptr, (bf16_t*)(ow + (i ? WS_WOUTA1 : WS_WOUTA0)), false, gw, NGW, scr, lane);
    }
    {
      for (int it = gw; it < 1024; it += NGW) { const int mi = it >> 7, li = it & 127, kb = li >> 4, nb = li & 15; const int layer = mi >> 2, grp = mi & 3;
          bf16_t* dst = (bf16_t*)(ow + (layer ? WS_WG1 : WS_WG0)) + (size_t)grp * 512 * 512;
          transpose_item(w_grp_a + (size_t)mi * 512 * 512, 512, 32 * nb, nullptr, dst, 512, 32 * nb, scr, 64 * kb, lane); } }
}
__device__ __forceinline__ void convert_bweights(const Params& p, LAS unsigned char* lds, int lv, int LG) {
    const int tid = tid_l(), lane = tid & 63, wave = tid >> 6; unsigned char* ws = p.ws; unsigned char* ow = (unsigned char*)p.out;
    LAS float* scr = (LAS float*)(lds + wave * 16384); const int gw = lv * 8 + wave, NGW = LG * 8;
    const float* norm_kv = p.in[6]; const float* w_k = p.in[7]; const float* w_v = p.in[8]; const float* norm_b = p.in[9]; const float* w_in_b = p.in[10]; const float* w_out_b = p.in[11];
    bf16_t* sa = (bf16_t*)(ws + WS_SLOTA);
    convert_job(w_k, D, 0, D, D, norm_kv, sa, true, gw, NGW, scr, lane);
    convert_job(w_v, D, 0, D, D, norm_kv, sa + (size_t)D * D, false, gw, NGW, scr, lane);
    convert_job(w_in_b, 4 * D, 0, D, 3 * D, norm_b, sa + (size_t)2 * D * D, true, gw, NGW, scr, lane);
    convert_job(w_in_b, 4 * D, 3 * D, D, D, norm_b, sa + (size_t)5 * D * D, false, gw, NGW, scr, lane);
    convert_job(w_out_b, D, 0, D, D, nullptr, (bf16_t*)(ws + WS_WOUTB0), false, gw, NGW, scr, lane);
    bf16_t* sb = (bf16_t*)(ow + OUT_WINB1);
    convert_job(w_in_b + (size_t)D * 4 * D, 4 * D, 0, D, 3 * D, norm_b + D, sb, true, gw, NGW, scr, lane);
    convert_job(w_in_b + (size_t)D * 4 * D, 4 * D, 3 * D, D, D, norm_b + D, sb + (size_t)3 * D * D, false, gw, NGW, scr, lane);
    convert_job(w_out_b + (size_t)D * D, D, 0, D, D, nullptr, (bf16_t*)(ow + OUT_WOUTB1), false, gw, NGW, scr, lane);
}

__device__ __forceinline__ void pool_phase(const bf16_t* __restrict__ z, const bf16_t* __restrict__ sg, const float* __restrict__ scale, bf16_t* __restrict__ h, int lv, int LG, int half) {
    const int nthr = LG * 512;
    for (int it0 = lv * 512 + tid_l(); it0 < 256 * 256; it0 += nthr) { const int item = half * 256 * 256 + it0;
        const int cc = item & 255, seg = item >> 8; const int t0 = seg * 32, s0 = t0 & (SEQ - 1); const int w = 2 << (cc >> 6);
        const bf16_t* up = z + (size_t)t0 * D + cc * 8; const bf16_t* gp = sg + (size_t)t0 * D + cc * 8; bf16_t* pp = h + (size_t)t0 * D + cc * 8;
        const f32x4 sc0 = *(const f32x4*)(scale + cc * 8), sc1 = *(const f32x4*)(scale + cc * 8 + 4);
        const float scv[8] = {sc0[0], sc0[1], sc0[2], sc0[3], sc1[0], sc1[1], sc1[2], sc1[3]};
        float sum[8];
#pragma unroll
        for (int j = 0; j < 8; ++j) sum[j] = 0.f;
        if (s0 > 0) for (int k = 1; k < w; ++k) { const u32x4 v = *(const u32x4*)(up - (size_t)k * D);
            sum[0] += bf_lo(v.x); sum[1] += bf_hi(v.x); sum[2] += bf_lo(v.y); sum[3] += bf_hi(v.y); sum[4] += bf_lo(v.z); sum[5] += bf_hi(v.z); sum[6] += bf_lo(v.w); sum[7] += bf_hi(v.w); }
#pragma unroll 8
        for (int i = 0; i < 32; ++i) { const int s = s0 + i; const u32x4 v = *(const u32x4*)(up + (size_t)i * D), gq = *(const u32x4*)(gp + (size_t)i * D);
            float c[8] = {bf_lo(v.x), bf_hi(v.x), bf_lo(v.y), bf_hi(v.y), bf_lo(v.z), bf_hi(v.z), bf_lo(v.w), bf_hi(v.w)};
            const float gt[8] = {bf_lo(gq.x), bf_hi(gq.x), bf_lo(gq.y), bf_hi(gq.y), bf_lo(gq.z), bf_hi(gq.z), bf_lo(gq.w), bf_hi(gq.w)};
            const float rc = 1.0f / (float)((s + 1 < w) ? (s + 1) : w); float o[8];
#pragma unroll
            for (int j = 0; j < 8; ++j) { sum[j] += c[j]; o[j] = (sum[j] * rc - c[j]) * scv[j] * gt[j]; }
            u32x4 ov; ov.x = cvt_pk_bf16(o[0], o[1]); ov.y = cvt_pk_bf16(o[2], o[3]); ov.z = cvt_pk_bf16(o[4], o[5]); ov.w = cvt_pk_bf16(o[6], o[7]);
            *(u32x4*)(pp + (size_t)i * D) = ov;
            if (s - w + 1 >= 0) { const u32x4 r = *(const u32x4*)(up + (ptrdiff_t)(i - w + 1) * D);
                sum[0] -= bf_lo(r.x); sum[1] -= bf_hi(r.x); sum[2] -= bf_lo(r.y); sum[3] -= bf_hi(r.y); sum[4] -= bf_lo(r.z); sum[5] -= bf_hi(r.z); sum[6] -= bf_lo(r.w); sum[7] -= bf_hi(r.w); } }
    }
}

__device__ __forceinline__ void final_norm(const bf16_t* xb, float* out, const float* ssq, const float* gam, int lv, int LG, int rbeg, int nrows) {
    const int tidf = tid_l(); const int lane = tidf & 63, wave = tidf >> 6;
    for (int r0 = lv * 8 + wave; r0 < nrows; r0 += LG * 8) { const int row = rbeg + r0; const float inv = rsqrtf(ssq[row] * (1.0f / D) + RMS_EPS); const u32x4* xr = (const u32x4*)(xb + (size_t)row * D) + lane; f32x4* orow = (f32x4*)(out + (size_t)row * D) + 2 * lane; const f32x4* gr = (const f32x4*)gam + 2 * lane;
#pragma unroll
        for (int j = 0; j < 4; ++j) { const u32x4 v = xr[64 * j]; const f32x4 g0 = gr[128 * j], g1 = gr[128 * j + 1];
            f32x4 a = (f32x4){bf_lo(v.x), bf_hi(v.x), bf_lo(v.y), bf_hi(v.y)}, b = (f32x4){bf_lo(v.z), bf_hi(v.z), bf_lo(v.w), bf_hi(v.w)};
            __builtin_nontemporal_store(a * inv * g0, orow + 128 * j); __builtin_nontemporal_store(b * inv * g1, orow + 128 * j + 1); } }
}

__device__ __forceinline__ s16x4 tr_read(unsigned addr) { s16x4 r; asm volatile("ds_read_b64_tr_b16 %0, %1" : "=&v"(r) : "v"(addr) : "memory"); return r; }
struct AUnit { int g, b, h, r, n; };
template <int PH> __device__ __forceinline__ AUnit attn_decode(int u, int half) {
    AUnit a; int bh;
    if (PH == 0) { const int k = u >> 7, x = (u >> 5) & 3, j = u & 31; a.g = 1 + (k & 1); bh = 32 * half + 4 * (k >> 1) + x; if (a.g == 1) { a.n = j & 7; a.r = j >> 3; } else { a.n = j & 1; a.r = j >> 1; } }
    else { a.g = 0; a.n = u & 31; a.r = 0; bh = 32 * half + (u >> 5); }
    a.b = bh >> 4; a.h = bh & 15; return a;
}
template <int IS_V> __device__ __forceinline__ void attn_dma(LAS unsigned char* tile, const bf16_t* src, const AUnit& a, int w, int lane) {
    const int dsh = 2 * a.g; const int rsub = lane >> 4, pc = lane & 15;
    const unsigned hbase = (unsigned)(((a.b * NH + a.h) * SEQ + a.r) * 256);
#pragma unroll
    for (int it = 0; it < 8; ++it) { const int row = 32 * w + 4 * it + rsub; int pk = (a.n - 1) * 128 + row; pk = pk < 0 ? 0 : pk;
        const int f = IS_V ? 2 * (row & 7) : (row & 15);
        const unsigned goff = hbase + ((unsigned)(pk * 256) << dsh) + 16u * (unsigned)(pc ^ f);
        __builtin_amdgcn_global_load_lds((const unsigned*)((const char*)src + (size_t)goff), (LAS unsigned*)(tile + (32 * w + 4 * it) * 256), 16, 0, 0); }
}
template <int OFF> __device__ __forceinline__ s16x4 tr_read_o(unsigned addr) { s16x4 r; asm volatile("ds_read_b64_tr_b16 %0, %1 offset:%2" : "=&v"(r) : "v"(addr), "i"(OFF) : "memory"); return r; }
template <int PH>
__device__ __forceinline__ void attn_phase(LAS unsigned char* lds, const bf16_t* Kb, const bf16_t* Vb, bf16_t* Qb, bf16_t* sg, float* lse, int vcu, int G, int half) {
    const int nunits = PH == 0 ? 2048 : 1024;
    int tid_ = threadIdx.x; asm volatile("" : "+v"(tid_));
    const int tid = tid_, w = __builtin_amdgcn_readfirstlane(tid >> 6), lane = tid & 63, ln = lane & 15, q = lane >> 4;
    const int i = 16 * w + ln;
    LAS unsigned char* Kt = lds; LAS unsigned char* Vt = lds + 65536;
    __syncthreads();
    for (int z = tid; z < 256; z += 512) *(LAS u32x4*)(Vt + 65536 + z * 16) = (u32x4){0u, 0u, 0u, 0u};
    const LAS unsigned char* kb4[4]; unsigned vb8[8];
    { const int k7 = (4 * q + (ln >> 2)) & 7;
#pragma unroll
      for (int c = 0; c < 4; ++c) kb4[c] = Kt + (16 * w + ln) * 256 + 16 * ((4 * c + q) ^ ln);
#pragma unroll
      for (int db = 0; db < 8; ++db) vb8[db] = (unsigned)(uintptr_t)Vt + (16 * w + 4 * q + (ln >> 2)) * 256 + 16 * ((ln & 3) >> 1) + 8 * (ln & 1) + 32 * (db ^ k7); }
    int u = vcu;
    if (u < nunits) {
        AUnit a = attn_decode<PH>(u, half);
        bf16x8 qn[4];
        attn_dma<0>(Kt, Kb, a, w, lane);
        { const int sq0 = ((a.n * 128 + i) << (2 * a.g)) + a.r; const bf16_t* qp0 = Qb + ((size_t)((a.g * 4 + a.b) * NH + a.h) * SEQ + sq0) * 128;
#pragma unroll
          for (int c = 0; c < 4; ++c) qn[c] = *(const bf16x8*)(qp0 + 32 * c + 8 * q); }
        for (;;) {
            const int dsh = 2 * a.g, n = a.n, g = a.g, h = a.h;
            const int sq = ((n * 128 + i) << dsh) + a.r; const size_t qrow = (size_t)(a.b * SEQ + sq);
            bf16_t* qp = Qb + ((size_t)((g * 4 + a.b) * NH + h) * SEQ + sq) * 128;
            asm volatile("s_waitcnt vmcnt(0)" ::: "memory");
            __syncthreads();
            attn_dma<1>(Vt, Vb, a, w, lane);
            bf16x8 qf[4];
#pragma unroll
            for (int c = 0; c < 4; ++c) qf[c] = qn[c];
            const int un = u + G; const bool has_next = un < nunits; AUnit an = a;
            if (has_next) an = attn_decode<PH>(un, half);
            f32x4 s[10];
            { bf16x8 kf[2][4];
#define AT_LOADK(buf, jt_) do { _Pragma("unroll") for (int c = 0; c < 4; ++c) kf[buf][c] = *(const LAS bf16x8*)(kb4[c] + 4096 * (jt_)); } while (0)
              AT_LOADK(0, 0);
#pragma unroll
              for (int jt = 0; jt < 9; ++jt) {
                  if (jt + 1 < 9) AT_LOADK((jt + 1) & 1, jt + 1);
                  __builtin_amdgcn_sched_barrier(0);
                  f32x4 acc = (f32x4){0.f, 0.f, 0.f, 0.f};
#pragma unroll
                  for (int c = 0; c < 4; ++c) acc = __builtin_amdgcn_mfma_f32_16x16x32_bf16(kf[jt & 1][c], qf[c], acc, 0, 0, 0);
                  s[jt] = acc;
                  __builtin_amdgcn_sched_barrier(0);
              }
#undef AT_LOADK
            }
            float mx = -1e30f; const int e0 = 4 * q - ln;
#pragma unroll
            for (int jt = 0; jt < 9; ++jt) { const int tl = w + jt; const bool tv = (tl < 16) && (n > 0 || tl >= 8);
#pragma unroll
                for (int j = 0; j < 4; ++j) { bool ok = tv; if (jt == 0) ok = ok && (e0 + j >= 0); if (jt == 8) ok = ok && (e0 + j <= 0);
                    const float v = ok ? s[jt][j] : -1e30f; s[jt][j] = v; mx = fmaxf(mx, v); } }
            mx = fmaxf(mx, __shfl_xor(mx, 16)); mx = fmaxf(mx, __shfl_xor(mx, 32));
            float l = 0.f;
#pragma unroll
            for (int jt = 0; jt < 9; ++jt)
#pragma unroll
                for (int j = 0; j < 4; ++j) { const float pv = __builtin_amdgcn_exp2f(s[jt][j] - mx); s[jt][j] = pv; l += pv; }
            s[9] = (f32x4){0.f, 0.f, 0.f, 0.f};
            l += __shfl_xor(l, 16); l += __shfl_xor(l, 32);
            u32x4 pbu[5];
#pragma unroll
            for (int ch = 0; ch < 5; ++ch) { pbu[ch].x = cvt_pk_bf16(s[2 * ch][0], s[2 * ch][1]); pbu[ch].y = cvt_pk_bf16(s[2 * ch][2], s[2 * ch][3]); pbu[ch].z = cvt_pk_bf16(s[2 * ch + 1][0], s[2 * ch + 1][1]); pbu[ch].w = cvt_pk_bf16(s[2 * ch + 1][2], s[2 * ch + 1][3]); }
            asm volatile("s_waitcnt vmcnt(0)" ::: "memory");
            __syncthreads();
            if (has_next) { attn_dma<0>(Kt, Kb, an, w, lane);
                const int sqn = ((an.n * 128 + i) << (2 * an.g)) + an.r; const bf16_t* qpn = Qb + ((size_t)((an.g * 4 + an.b) * NH + an.h) * SEQ + sqn) * 128;
#pragma unroll
                for (int c = 0; c < 4; ++c) qn[c] = *(const bf16x8*)(qpn + 32 * c + 8 * q); }
            u32x2 a1[8], a2[8], gg[8]; float L1 = 0.f, L2 = 0.f; bf16_t* gp = sg + qrow * D + h * 128;
            if (PH == 1) { const bf16_t* q1 = qp + (size_t)4 * NH * SEQ * 128; const bf16_t* q2 = qp + (size_t)8 * NH * SEQ * 128;
                L1 = lse[qrow * NH + h]; L2 = lse[(size_t)T * NH + qrow * NH + h];
#pragma unroll
                for (int db = 0; db < 8; ++db) { a1[db] = *(const u32x2*)(q1 + 16 * db + 4 * q); a2[db] = *(const u32x2*)(q2 + 16 * db + 4 * q); gg[db] = *(const u32x2*)(gp + 16 * db + 4 * q); } }
            f32x4 o[8];
#pragma unroll
            for (int db = 0; db < 8; ++db) o[db] = (f32x4){0.f, 0.f, 0.f, 0.f};
            { s16x4 lo[2][4], hi[2][4];
#define AT_TRISSUE(buf, st_) do { _Pragma("unroll") for (int d4 = 0; d4 < 4; ++d4) { lo[buf][d4] = tr_read_o<4096 * (2 * ((st_) >> 1))>(vb8[4 * ((st_) & 1) + d4]); hi[buf][d4] = tr_read_o<4096 * (2 * ((st_) >> 1) + 1)>(vb8[4 * ((st_) & 1) + d4]); } } while (0)
#define AT_PVSTEP(st_) do { \
                  if ((st_) + 1 < 10) { AT_TRISSUE(((st_) + 1) & 1, ((st_) + 1 < 10 ? (st_) + 1 : 9)); asm volatile("s_waitcnt lgkmcnt(8)" ::: "memory"); } \
                  else asm volatile("s_waitcnt lgkmcnt(0)" ::: "memory"); \
                  __builtin_amdgcn_sched_barrier(0); \
                  { union { u32x4 uu; bf16x8 v; } pb; pb.uu = pbu[(st_) >> 1]; \
                    _Pragma("unroll") for (int d4 = 0; d4 < 4; ++d4) { const bf16x8 vf = (bf16x8){lo[(st_) & 1][d4][0], lo[(st_) & 1][d4][1], lo[(st_) & 1][d4][2], lo[(st_) & 1][d4][3], hi[(st_) & 1][d4][0], hi[(st_) & 1][d4][1], hi[(st_) & 1][d4][2], hi[(st_) & 1][d4][3]}; \
                      o[4 * ((st_) & 1) + d4] = __builtin_amdgcn_mfma_f32_16x16x32_bf16(vf, pb.v, o[4 * ((st_) & 1) + d4], 0, 0, 0); } } \
                  __builtin_amdgcn_sched_barrier(0); } while (0)
              AT_TRISSUE(0, 0);
              AT_PVSTEP(0); AT_PVSTEP(1); AT_PVSTEP(2); AT_PVSTEP(3); AT_PVSTEP(4); AT_PVSTEP(5); AT_PVSTEP(6); AT_PVSTEP(7); AT_PVSTEP(8); AT_PVSTEP(9);
#undef AT_PVSTEP
#undef AT_TRISSUE
            }
            const float invl = 1.0f / l, L = mx + __builtin_amdgcn_logf(l);
            if (PH == 0) {
#pragma unroll
                for (int db = 0; db < 8; ++db) { u32x2 wv; wv.x = cvt_pk_bf16(o[db][0] * invl, o[db][1] * invl); wv.y = cvt_pk_bf16(o[db][2] * invl, o[db][3] * invl); *(u32x2*)(qp + 16 * db + 4 * q) = wv; }
                if (q == 0) lse[(size_t)(g - 1) * T * NH + qrow * NH + h] = L;
            } else {
                const float Lm = fmaxf(L, fmaxf(L1, L2));
                const float x0 = __builtin_amdgcn_exp2f(L - Lm), x1 = __builtin_amdgcn_exp2f(L1 - Lm), x2 = __builtin_amdgcn_exp2f(L2 - Lm); const float inv = 1.0f / (x0 + x1 + x2);
                const float w0 = x0 * inv * invl, w1 = x1 * inv, w2 = x2 * inv;
#pragma unroll
                for (int db = 0; db < 8; ++db) {
                    const float r0 = (w0 * o[db][0] + w1 * bf_lo(a1[db].x) + w2 * bf_lo(a2[db].x)) * bf_lo(gg[db].x), r1 = (w0 * o[db][1] + w1 * bf_hi(a1[db].x) + w2 * bf_hi(a2[db].x)) * bf_hi(gg[db].x);
                    const float r2 = (w0 * o[db][2] + w1 * bf_lo(a1[db].y) + w2 * bf_lo(a2[db].y)) * bf_lo(gg[db].y), r3 = (w0 * o[db][3] + w1 * bf_hi(a1[db].y) + w2 * bf_hi(a2[db].y)) * bf_hi(gg[db].y);
                    u32x2 wv; wv.x = cvt_pk_bf16(r0, r1); wv.y = cvt_pk_bf16(r2, r3); *(u32x2*)(gp + 16 * db + 4 * q) = wv; }
            }
            if (!has_next) break;
            u = un; a = an;
        }
    }
    __syncthreads();
}

#define XB_TMO      128
#define XB_XCNT(j)  (256  + 64 * (j))
#define XB_XSUB(j)  (1280 + 64 * (j))
#define XB_XGEN(j)  (2304 + 64 * (j))
#define XB_TOP      3328
#define XB_TOPGEN   3392
#define XCD_BAR_WORDS 3456
#define XB_SPIN_CAP (1u << 18)

__device__ __forceinline__ unsigned xb_ld(unsigned* p)              { return __hip_atomic_load(p, __ATOMIC_RELAXED, __HIP_MEMORY_SCOPE_AGENT); }
__device__ __forceinline__ unsigned xb_add(unsigned* p, unsigned v) { return __hip_atomic_fetch_add(p, v, __ATOMIC_RELAXED, __HIP_MEMORY_SCOPE_AGENT); }
__device__ __forceinline__ unsigned xb_xcc_id() { return (unsigned)__builtin_amdgcn_s_getreg((3 << 11) | 20) & 0xFu; }
#define XB_SPIN(cond, bar) do { unsigned _sp = 0; while (cond) { __builtin_amdgcn_s_sleep(1); \
    if ((++_sp & 255u) == 0u) { if (xb_ld(&(bar)[XB_TMO])) break; if (_sp > XB_SPIN_CAP) { atomicAdd(&(bar)[XB_TMO], 1u); break; } } } } while (0)

struct XcdBarrier {
    unsigned gsz;
    unsigned* bar; unsigned x;
    volatile LAS unsigned* st;
};

__device__ __forceinline__ XcdBarrier xcd_barrier_post(unsigned* bar, volatile LAS unsigned* st, unsigned gsz) {
    XcdBarrier b; b.gsz = gsz; b.bar = bar; b.x = xb_xcc_id(); b.st = st;
    if (threadIdx.x == 0) (void)xb_add(&bar[XB_XCNT(b.x)], 1u);
    return b;
}
__device__ __forceinline__ void xcd_barrier_complete(unsigned* bar, unsigned x, unsigned& nloc, unsigned& nx, unsigned G) {
    unsigned sum, cnt, mine, sp = 0u;
    for (;;) {
        sum = 0u; cnt = 0u; mine = 0u;
#pragma unroll
        for (unsigned j = 0; j < 16; ++j) { const unsigned c = xb_ld(&bar[XB_XCNT(j)]); sum += c; cnt += (c > 0u) ? 1u : 0u; mine = (j == x) ? c : mine; }
        if (sum == G) break;
        __builtin_amdgcn_s_sleep(1);
        if ((++sp & 255u) == 0u) { if (xb_ld(&bar[XB_TMO])) break; if (sp > XB_SPIN_CAP) { atomicAdd(&bar[XB_TMO], 1u); break; } }
    }
    nloc = mine > 0u ? mine : 1u; nx = cnt > 0u ? cnt : 1u;
}

__device__ __forceinline__ void xcd_barrier(const XcdBarrier& b) {
    asm volatile("s_waitcnt vmcnt(0)" ::: "memory");
    __syncthreads();
    if (threadIdx.x == 0) {
        unsigned* bar = b.bar;
        __builtin_amdgcn_s_waitcnt(0);
        unsigned nloc = b.st[0], nx = b.st[1];
        if (nloc == 0u) { xcd_barrier_complete(bar, b.x, nloc, nx, b.gsz); b.st[0] = nloc; b.st[1] = nx; }
        const unsigned old = xb_add(&bar[XB_XSUB(b.x)], 1u);
        const unsigned gen = old / nloc;
        if (old + 1u == (gen + 1u) * nloc) {
            __builtin_amdgcn_fence(__ATOMIC_RELEASE, "agent");
            asm volatile("s_waitcnt vmcnt(0)" ::: "memory");
            const unsigned og = xb_add(&bar[XB_TOP], 1u);
            const unsigned tg = og / nx;
            if (og + 1u == (tg + 1u) * nx) xb_add(&bar[XB_TOPGEN], 1u);
            else XB_SPIN(xb_ld(&bar[XB_TOPGEN]) == tg, bar);
            __builtin_amdgcn_fence(__ATOMIC_ACQUIRE, "agent");
            xb_add(&bar[XB_XGEN(b.x)], 1u);
            asm volatile("s_waitcnt vmcnt(0)" ::: "memory");
        } else {
            XB_SPIN(xb_ld(&bar[XB_XGEN(b.x)]) == gen, bar);
            __builtin_amdgcn_fence(__ATOMIC_ACQUIRE, "agent");
            asm volatile("s_waitcnt vmcnt(0)" ::: "memory");
        }
    }
    __syncthreads();
}

__device__ __forceinline__ void flag_set(unsigned* f) { __hip_atomic_store(f, 1u, __ATOMIC_RELEASE, __HIP_MEMORY_SCOPE_AGENT); }
__device__ __forceinline__ void flag_wait(unsigned* f) {
    if (threadIdx.x == 0) { unsigned sp = 0u;
        while (__hip_atomic_load(f, __ATOMIC_RELAXED, __HIP_MEMORY_SCOPE_AGENT) == 0u) { __builtin_amdgcn_s_sleep(4); if (++sp > (1u << 22)) break; }
        __builtin_amdgcn_fence(__ATOMIC_ACQUIRE, "agent"); asm volatile("s_waitcnt vmcnt(0)" ::: "memory"); }
    __syncthreads();
}
__global__ void __launch_bounds__(512, 2) mega(Params p) {
    extern __shared__ __attribute__((aligned(16))) unsigned char lds_raw[];
    LAS unsigned char* lds = (LAS unsigned char*)lds_raw;
    cg::grid_group grid = cg::this_grid();
    const int G = gridDim.x, bx = blockIdx.x; const int vcu = (bx % 8) * (G / 8) + bx / 8;
    const int half = (bx % 8) >> 2, LG = G / 2, xq = bx % 4, idx = bx / 8;
    const int lv = xq * (G / 8) + idx;
    const int cl = 8 * (idx >> 1) + 2 * xq + (idx & 1);
    unsigned char* ws = p.ws; unsigned char* ow = (unsigned char*)p.out;
    float* ssq = (float*)(ws + WS_SSQ); float* lse = (float*)(ws + WS_LSE); const float* cosT = (const float*)(ws + WS_COS); const float* sinT = (const float*)(ws + WS_SIN);
    bf16_t* Kb = (bf16_t*)(ws + WS_K); bf16_t* Vb = (bf16_t*)(ws + WS_V); bf16_t* Qb = (bf16_t*)(ws + WS_Q);
    unsigned* flagB = (unsigned*)(ws + WS_FLAGS); unsigned* flagA = flagB + 64; unsigned* flagD = flagB + 128;
    if (threadIdx.x == 0) { volatile LAS unsigned* st = (volatile LAS unsigned*)(lds + LDS_BARST); st[0] = 0u; st[1] = 0u; st[2] = 0u; st[3] = 0u; }
    __syncthreads();
    XcdBarrier gbar = xcd_barrier_post((unsigned*)(ws + WS_BAR), (volatile LAS unsigned*)(lds + LDS_BARST), (unsigned)G);
    XcdBarrier hbar = xcd_barrier_post((unsigned*)(ws + WS_BAR) + 4096 * (1 + half), (volatile LAS unsigned*)(lds + LDS_BARST + 8), (unsigned)LG);
#define SEAM() xcd_barrier(hbar)
    prologue(p, lds, vcu, G); __syncthreads();
    xcd_barrier(gbar);
    unsigned* flagF = flagB + 192;
    if (half == 0) {
        pg8::Gemm g{(const bf16_t*)(ow + WS_WG0), (const bf16_t*)(ws + WS_WU), 2 * D, D, 512, 512, 0, D, 1}; pg8::StaticOrder S; S.init(2 * D, D, LG, cl);
        EpiFold E{(bf16_t*)(ow + WS_WINA0), (size_t)(WS_WINA1 - WS_WINA0) / 2}; pg8::gemm_phase<EpiFold, pg8::StaticOrder, true, true>(lds, g, S, E); SEAM();
        if (lv == 0 && threadIdx.x == 0) flag_set(flagF);
    } else {
        convert_bweights(p, lds, lv, LG); __syncthreads(); SEAM(); if (lv == 0 && threadIdx.x == 0) flag_set(flagB);
        flag_wait(flagF);
    }
#pragma unroll 1
    for (int layer = 0; layer < 2; ++layer) {
        bf16_t* xb_in = (bf16_t*)(ws + ((layer & 1) ? WS_BUF1 : WS_BUF0)); bf16_t* other = (bf16_t*)(ws + ((layer & 1) ? WS_BUF0 : WS_BUF1));
        bf16_t* zb = Kb; bf16_t* hb = Qb;
        { pg8::Gemm g{xb_in, (const bf16_t*)(ow + (layer ? WS_WINA1 : WS_WINA0)), T / 2, 2 * D, D, D, 0, D, 0}; pg8::HalfOrder S; S.init(T / 2, 2 * D, LG, cl); S.pmoff = 32 * half;
          EpiInA E{ssq + layer * T, zb, other};
          pg8::gemm_phase<EpiInA, pg8::HalfOrder, true, true>(lds, g, S, E); SEAM(); }
        { pool_phase(zb, other, p.in[4] + layer * D, hb, lv, LG, half); SEAM(); }
        { pg8::Gemm g{hb, (const bf16_t*)(ow + (layer ? WS_WOUTA1 : WS_WOUTA0)), T / 2, D, D, D, 0, D, 0}; pg8::HalfOrder S; S.init(T / 2, D, LG, cl); S.pmoff = 32 * half;
          EpiOut E{xb_in, other, ssq + (layer + 1) * T};
          pg8::gemm_phase<EpiOut, pg8::HalfOrder, true, true>(lds, g, S, E); SEAM(); }
    }
    if (half == 1) { if (lv == 0 && threadIdx.x == 0) flag_set(flagA); }
    else flag_wait(flagB);
#pragma unroll 1
    for (int lb = 0; lb < 2; ++lb) {
        const int layer = 2 + lb;
        bf16_t* xb_in = (bf16_t*)(ws + WS_BUF0); bf16_t* other = (bf16_t*)(ws + WS_BUF1);
        { const int N = lb == 0 ? 6 * D : 4 * D; pg8::Gemm g{xb_in, lb == 0 ? (const bf16_t*)(ws + WS_SLOTA) : (const bf16_t*)(ow + OUT_WINB1), T / 2, N, D, D, 0, D, 0}; pg8::HalfOrder S; S.init(T / 2, N, LG, cl); S.pmoff = 32 * half;
          EpiInB E{ssq + layer * T, cosT, sinT, Kb, Vb, Qb, other, lb == 0 ? 16 : 0};
          pg8::gemm_phase<EpiInB, pg8::HalfOrder, true, true>(lds, g, S, E); SEAM(); }
        { attn_phase<0>(lds, Kb, Vb, Qb, other, lse, lv, LG, half); SEAM(); }
        { attn_phase<1>(lds, Kb, Vb, Qb, other, lse, lv, LG, half); SEAM(); }
        { pg8::Gemm g{other, lb == 0 ? (const bf16_t*)(ws + WS_WOUTB0) : (const bf16_t*)(ow + OUT_WOUTB1), T / 2, D, D, D, 0, D, 0}; pg8::HalfOrder S; S.init(T / 2, D, LG, cl); S.pmoff = 32 * half;
          EpiOut E{xb_in, xb_in, ssq + (layer + 1) * T}; pg8::gemm_phase<EpiOut, pg8::HalfOrder, true, true>(lds, g, S, E); SEAM(); }
    }
    unsigned* flagE = flagB + 160;
    if (half == 0) { if (lv == 0 && threadIdx.x == 0) flag_set(flagD); flag_wait(flagA);
        final_norm((const bf16_t*)(ws + WS_BUF0), p.out, ssq + 4 * T, p.in[12], lv, LG, 0, T / 2);
        flag_wait(flagE);
        final_norm((const bf16_t*)(ws + WS_BUF0), p.out, ssq + 4 * T, p.in[12], lv, LG, 3 * (T / 4), T / 4);
    } else { if (lv == 0 && threadIdx.x == 0) flag_set(flagE); flag_wait(flagD);
        final_norm((const bf16_t*)(ws + WS_BUF0), p.out, ssq + 4 * T, p.in[12], lv, LG, T / 2, T / 4); }
    if (p.ph_hi == 12345) grid.sync();
#undef SEAM
}

extern "C" void kernel_launch(void* const* d_in, const int* in_sizes, int n_in, void* d_out, int out_size, void* d_ws, size_t ws_size, hipStream_t stream) {
    static int grid = 0;
    if (grid == 0) {
        if (n_in != 13 || out_size != T * D || ws_size < WS_END) { fprintf(stderr, "kernel_launch: unexpected shapes (n_in %d out %d ws %zu); nothing launched\n", n_in, out_size, ws_size); grid = -1; return; }
        int dev = 0, cus = 0, per_cu = 0;
        if (hipGetDevice(&dev) != hipSuccess || hipDeviceGetAttribute(&cus, hipDeviceAttributeMultiprocessorCount, dev) != hipSuccess) { grid = -1; return; }
        if (hipFuncSetAttribute((const void*)mega, hipFuncAttributeMaxDynamicSharedMemorySize, LDS_BYTES) != hipSuccess) { fprintf(stderr, "kernel_launch: hipFuncSetAttribute failed\n"); grid = -1; return; }
        if (hipOccupancyMaxActiveBlocksPerMultiprocessor(&per_cu, (const void*)mega, 512, LDS_BYTES) != hipSuccess || per_cu < 1) { fprintf(stderr, "kernel_launch: occupancy query gave %d\n", per_cu); per_cu = 1; }
        (void)hipGetLastError();
        grid = cus * per_cu;
        if (grid % 16 != 0) { fprintf(stderr, "kernel_launch: the two half-grids need a workgroup count that is a multiple of 16 (got %d); nothing launched\n", grid); grid = -1; return; }
    }
    if (grid < 0) return;
    Params p{};
    for (int i = 0; i < 13; ++i) p.in[i] = (const float*)d_in[i];
    p.out = (float*)d_out; p.ws = (unsigned char*)d_ws; p.ph_lo = 0; p.ph_hi = 1;
    if (hipMemsetAsync((unsigned char*)d_ws + WS_BAR, 0, (3 * 4096 + 256) * 4, stream) != hipSuccess) { fprintf(stderr, "kernel_launch: hipMemsetAsync failed; nothing launched\n"); return; }
    void* args[] = {&p};
    hipError_t e = hipLaunchCooperativeKernel((const void*)mega, dim3(grid), dim3(512), args, LDS_BYTES, stream);
    if (e != hipSuccess) fprintf(stderr, "kernel_launch: cooperative launch failed: %s (grid %d)\n", hipGetErrorString(e), grid);
}
```

```cpp
#include <hip/hip_runtime.h>
#include <hip/hip_cooperative_groups.h>
#include <cstdio>
#include <cstdint>
namespace cg = cooperative_groups;
namespace pg8 {
#define PG8_LAS __attribute__((address_space(3)))
typedef unsigned short bf16_t;
typedef short bf16x8 __attribute__((ext_vector_type(8)));
typedef float f32x4 __attribute__((ext_vector_type(4)));
typedef unsigned u32x4 __attribute__((ext_vector_type(4)));
constexpr int BM = 256, BK = 64, HALF = 128, HTB = HALF * BK * 2  , STAGE_BYTES = 8 * HTB, NXCD = 8, WGM = 8;

__host__ __device__ __forceinline__ int lds_byte(int r, int c) { const int st = (r >> 4) * 2 + (c >> 5), rr = r & 15, cc = c & 31, ob = rr * 64 + cc * 2; return st * 1024 + (ob ^ (((ob >> 9) & 1) << 5)); }
__host__ __device__ __forceinline__ void stage_rc(int b, int& R, int& C) { const int st = b / 1024, sb = b % 1024, swz = sb ^ (((sb >> 9) & 1) << 5); R = (st >> 1) * 16 + swz / 64; C = (st & 1) * 32 + (swz % 64) / 2; }
__host__ __device__ __forceinline__ int perm32(int rho) { const int n = rho >> 4, i = rho & 15; return 8 * (i >> 2) + 4 * n + (i & 3); }

struct Unit { int pm, pn; };
struct Gemm { const bf16_t* A; const bf16_t* Bt; int M, N, K, lda, agrp, ldb, bmode; };

struct StaticOrder {
    int nM, nN, nwg, G, c;
    __host__ __device__ void init(int M, int N, int G_, int c_) { nM = M / BM; nN = N / BM; nwg = nM * nN; G = G_; c = c_; }
    __host__ __device__ bool next(int i, Unit& u) const {
        const long L = (long)i * G + c; if (L >= nwg) return false;
        int wgid = (int)L; { const int q = nwg / NXCD, r = nwg % NXCD, xcd = wgid % NXCD, off = wgid / NXCD; wgid = (xcd < r ? xcd * (q + 1) : r * (q + 1) + (xcd - r) * q) + off; }
        const int nig = WGM * nN, gid = wgid / nig, fm = gid * WGM, gsz = (nM - fm) < WGM ? (nM - fm) : WGM;
        u.pm = fm + ((wgid % nig) % gsz); u.pn = (wgid % nig) / gsz; return true;
    }
    __device__ __forceinline__ void a_ready(const Unit&) const {}
    __device__ __forceinline__ void done(const Unit&) const {}
};

struct HalfOrder : StaticOrder { int pmoff;
    __host__ __device__ static int kind_perm(int p, int nN) {
        if (nN == 48) return p < 8 ? p : p < 16 ? p + 8 : p < 20 ? p - 8 : p < 24 ? p + 20 : p < 40 ? p : p < 44 ? p - 28 : p;
        if (nN == 32) return p < 12 ? p : p < 16 ? p + 12 : p < 28 ? p - 4 : p;
        if (nN == 16) return p < 4 ? p : p < 8 ? p + 4 : p < 12 ? p - 4 : p;
        return p; }
    __host__ __device__ bool next(int i, Unit& u) const { const bool r = StaticOrder::next(i, u); u.pm += pmoff; u.pn = kind_perm(u.pn, nN); return r; } };
__device__ __forceinline__ unsigned cvt_pk_bf16(float lo, float hi) { unsigned r; asm volatile("v_cvt_pk_bf16_f32 %0, %1, %2" : "=v"(r) : "v"(lo), "v"(hi)); return r; }
typedef float f32x2 __attribute__((ext_vector_type(2)));
template <class Epi, class Sched, bool ALIGN_EPI = false, bool SP2 = false>
__device__ __forceinline__ void gemm_phase(PG8_LAS unsigned char* lds, const Gemm g, const Sched& S, const Epi& E) {
    int tid_ = threadIdx.x; asm volatile("" : "+v"(tid_));
    const int tid = tid_, wid = __builtin_amdgcn_readfirstlane(tid >> 6), lane = tid & 63, wr = wid >> 2, wc = wid & 3, fr = lane & 15, fq = lane >> 4;
    const int K = g.K, nt = K / BK;
    unsigned voffA[2], voffB[2];
#pragma unroll
    for (int i = 0; i < 2; ++i) { int R, C; stage_rc(tid * 16 + i * 8192, R, C); const int Rb = Epi::PERM ? ((R & ~31) + perm32(R & 31)) : R;
        voffA[i] = (unsigned)(R * g.lda + C) * 2u; voffB[i] = (unsigned)(Rb * g.ldb + C) * 2u; }
    const size_t kstep = (size_t)(BK * 2);
    const size_t hstep = (size_t)HALF * g.ldb * 2;
    const size_t tstep = 2 * hstep;
    const size_t hstepA = (size_t)HALF * g.lda * 2, tstepA = 2 * hstepA;
    const unsigned ldsw = (unsigned)wid * 1024u;
    const int aoff = lds_byte(wr * 64 + fr, fq * 8), boff = lds_byte(wc * 32 + fr, fq * 8);
#define PG8_SA(b, h) (((b) * 2 + (h)) * HTB)
#define PG8_SB(b, h) ((4 + (b) * 2 + (h)) * HTB)
#define PG8_STAGE(bufoff, gbase, voff) do { _Pragma("unroll") for (int _i = 0; _i < 2; ++_i) \
        __builtin_amdgcn_global_load_lds((const unsigned*)((const char*)(gbase) + (voff)[_i]), (PG8_LAS unsigned*)(lds + (bufoff) + ldsw + _i * 8192), 16, 0, 0); } while (0)
#define PG8_LDA(dst, b, h) do { _Pragma("unroll") for (int m = 0; m < 4; ++m) _Pragma("unroll") for (int k = 0; k < 2; ++k) dst[m][k] = *(const PG8_LAS bf16x8*)(lds + PG8_SA(b, h) + aoff + m * 2048 + k * 1024); } while (0)
#define PG8_LDB(dst, b, h) do { _Pragma("unroll") for (int n = 0; n < 2; ++n) _Pragma("unroll") for (int k = 0; k < 2; ++k) dst[n][k] = *(const PG8_LAS bf16x8*)(lds + PG8_SB(b, h) + boff + n * 2048 + k * 1024); } while (0)
#define PG8_MMA(ai, bj, At, Bt) do { __builtin_amdgcn_s_setprio(1); _Pragma("unroll") for (int m = 0; m < 4; ++m) _Pragma("unroll") for (int n = 0; n < 2; ++n) _Pragma("unroll") for (int k = 0; k < 2; ++k) \
        acc[ai][bj][m][n] = __builtin_amdgcn_mfma_f32_16x16x32_bf16(Bt[n][k], At[m][k], acc[ai][bj][m][n], 0, 0, 0); __builtin_amdgcn_s_setprio(0); } while (0)
#define PG8_WAIT_V(n) asm volatile("s_waitcnt vmcnt(" #n ")" ::: "memory")
#define PG8_WAIT_L(n) asm volatile("s_waitcnt lgkmcnt(" #n ")" ::: "memory")
#define PG8_BAR __builtin_amdgcn_s_barrier()
#define PG8_SCHED __builtin_amdgcn_sched_barrier(0)
    Unit cur, nxt; int ui = 0;
    if (!S.next(0, cur)) return;
    f32x4 acc[2][2][4][2];
#pragma unroll
    for (int a = 0; a < 2; ++a)
#pragma unroll
        for (int b = 0; b < 2; ++b)
#pragma unroll
            for (int m = 0; m < 4; ++m)
#pragma unroll
                for (int n = 0; n < 2; ++n) acc[a][b][m][n] = (f32x4){0.f, 0.f, 0.f, 0.f};
    bf16x8 At[4][2], B0[2][2], B1[2][2];
    const char* cA = (const char*)g.A + (size_t)cur.pm * tstepA + (size_t)((cur.pn >> 1) * g.agrp) * 2; const char* cB = (const char*)g.Bt + (size_t)cur.pn * tstep + (g.bmode ? ((size_t)(cur.pm >> 3) * 2048 * 2048 + (size_t)((cur.pm >> 1) & 3) * 512) * 2 : (size_t)0);
    S.a_ready(cur);
    if constexpr (SP2) {
        PG8_STAGE(PG8_SB(0, 0), cB, voffB); PG8_STAGE(PG8_SB(0, 1), cB + hstep, voffB); PG8_STAGE(PG8_SA(0, 0), cA, voffA); PG8_STAGE(PG8_SA(0, 1), cA + hstepA, voffA);
        if (wr == 1) PG8_BAR;
        PG8_WAIT_V(2); PG8_BAR;
        PG8_STAGE(PG8_SB(1, 0), cB + kstep, voffB); PG8_STAGE(PG8_SA(1, 0), cA + kstep, voffA); PG8_STAGE(PG8_SB(1, 1), cB + hstep + kstep, voffB);
        PG8_WAIT_V(6); PG8_BAR;
    } else {
        PG8_STAGE(PG8_SB(0, 0), cB, voffB); PG8_STAGE(PG8_SA(0, 0), cA, voffA); PG8_STAGE(PG8_SB(0, 1), cB + hstep, voffB); PG8_STAGE(PG8_SA(0, 1), cA + hstepA, voffA);
        if (wr == 1) PG8_BAR;
        PG8_WAIT_V(4); PG8_BAR;
        PG8_STAGE(PG8_SB(1, 0), cB + kstep, voffB); PG8_STAGE(PG8_SA(1, 0), cA + kstep, voffA); PG8_STAGE(PG8_SB(1, 1), cB + hstep + kstep, voffB);
        PG8_WAIT_V(6); PG8_BAR;
    }
    for (;;) {
        const bool has_next = S.next(ui + 1, nxt);
        const char* nA = has_next ? (const char*)g.A + (size_t)nxt.pm * tstepA + (size_t)((nxt.pn >> 1) * g.agrp) * 2 : cA; const char* nB = has_next ? (const char*)g.Bt + (size_t)nxt.pn * tstep + (g.bmode ? ((size_t)(nxt.pm >> 3) * 2048 * 2048 + (size_t)((nxt.pm >> 1) & 3) * 512) * 2 : (size_t)0) : cB;
        for (int t = 0; t < nt; t += 2) {
            const bool last = (t == nt - 2);
            const char* a1 = cA + (size_t)(t + 1) * kstep;
            const char* a2 = last ? nA : cA + (size_t)(t + 2) * kstep; const char* b2 = last ? nB : cB + (size_t)(t + 2) * kstep;
            const char* a3 = a2 + kstep; const char* b3 = b2 + kstep;
            if (last && has_next) S.a_ready(nxt);
            if constexpr (SP2) {
            PG8_LDB(B0, 0, 0); PG8_LDB(B1, 0, 1); PG8_SCHED; PG8_LDA(At, 0, 0); PG8_STAGE(PG8_SA(1, 1), a1 + hstepA, voffA);
            PG8_WAIT_V(8); PG8_WAIT_L(0); PG8_BAR; PG8_MMA(0, 0, At, B0); PG8_MMA(0, 1, At, B1); PG8_BAR; PG8_SCHED;
            PG8_LDA(At, 0, 1); PG8_STAGE(PG8_SB(0, 0), b2, voffB); PG8_STAGE(PG8_SB(0, 1), b2 + hstep, voffB); PG8_STAGE(PG8_SA(0, 0), a2, voffA);
            PG8_WAIT_V(8); PG8_WAIT_L(0); PG8_BAR; PG8_MMA(1, 0, At, B0); PG8_MMA(1, 1, At, B1); PG8_BAR; PG8_SCHED;
            PG8_LDB(B0, 1, 0); PG8_LDB(B1, 1, 1); PG8_SCHED; PG8_LDA(At, 1, 0); PG8_STAGE(PG8_SA(0, 1), a2 + hstepA, voffA);
            PG8_WAIT_V(8); PG8_WAIT_L(0); PG8_BAR; PG8_MMA(0, 0, At, B0); PG8_MMA(0, 1, At, B1); PG8_BAR; PG8_SCHED;
            PG8_LDA(At, 1, 1); PG8_STAGE(PG8_SB(1, 0), b3, voffB); PG8_STAGE(PG8_SB(1, 1), b3 + hstep, voffB); PG8_STAGE(PG8_SA(1, 0), a3, voffA);
            PG8_WAIT_V(8); PG8_WAIT_L(0); PG8_BAR; PG8_MMA(1, 0, At, B0); PG8_MMA(1, 1, At, B1); PG8_BAR; PG8_SCHED;
            } else {
            PG8_LDB(B0, 0, 0); PG8_SCHED; PG8_LDA(At, 0, 0); PG8_STAGE(PG8_SA(1, 1), a1 + hstepA, voffA);
            PG8_WAIT_L(8); PG8_BAR; PG8_WAIT_L(0); PG8_MMA(0, 0, At, B0); PG8_BAR; PG8_SCHED;
            PG8_LDB(B1, 0, 1); PG8_STAGE(PG8_SB(0, 0), b2, voffB);
            PG8_BAR; PG8_WAIT_L(0); PG8_MMA(0, 1, At, B1); PG8_BAR;
            PG8_LDA(At, 0, 1); PG8_STAGE(PG8_SA(0, 0), a2, voffA);
            PG8_BAR; PG8_WAIT_L(0); PG8_MMA(1, 0, At, B0); PG8_BAR; PG8_SCHED;
            PG8_STAGE(PG8_SB(0, 1), b2 + hstep, voffB);
            PG8_WAIT_V(6); PG8_BAR; PG8_MMA(1, 1, At, B1); PG8_BAR;
            PG8_LDB(B0, 1, 0); PG8_SCHED; PG8_LDA(At, 1, 0); PG8_STAGE(PG8_SA(0, 1), a2 + hstepA, voffA);
            PG8_WAIT_L(8); PG8_BAR; PG8_WAIT_L(0); PG8_MMA(0, 0, At, B0); PG8_BAR; PG8_SCHED;
            PG8_LDB(B1, 1, 1); PG8_STAGE(PG8_SB(1, 0), b3, voffB);
            PG8_BAR; PG8_WAIT_L(0); PG8_MMA(0, 1, At, B1); PG8_BAR;
            PG8_LDA(At, 1, 1); PG8_STAGE(PG8_SA(1, 0), a3, voffA);
            PG8_BAR; PG8_WAIT_L(0); PG8_MMA(1, 0, At, B0); PG8_BAR; PG8_SCHED;
            PG8_STAGE(PG8_SB(1, 1), b3 + hstep, voffB);
            PG8_WAIT_V(6); PG8_BAR; PG8_MMA(1, 1, At, B1); PG8_BAR;
            }
        }
        if constexpr (ALIGN_EPI) { if (wr == 0) PG8_BAR; }
        if constexpr (!Epi::AFTER_DRAIN) { E(acc, cur, wr, wc, fr, fq); S.done(cur); }
        if (!has_next) break;
#pragma unroll
        for (int a = 0; a < 2; ++a)
#pragma unroll
            for (int b = 0; b < 2; ++b)
#pragma unroll
                for (int m = 0; m < 4; ++m)
#pragma unroll
                    for (int n = 0; n < 2; ++n) acc[a][b][m][n] = (f32x4){0.f, 0.f, 0.f, 0.f};
        cur = nxt; cA = nA; cB = nB; ++ui;
        if constexpr (ALIGN_EPI) { if (wr == 1) PG8_BAR; }
    }
    PG8_WAIT_V(0);
    if constexpr (!ALIGN_EPI) { if (wr == 0) PG8_BAR; }
    PG8_BAR;
    if constexpr (Epi::AFTER_DRAIN) { E.fused(acc, cur, wr, wc, fr, fq, lds, wid, lane); S.done(cur); }
#undef PG8_SA
#undef PG8_SB
#undef PG8_STAGE
#undef PG8_LDA
#undef PG8_LDB
#undef PG8_MMA
#undef PG8_WAIT_V
#undef PG8_WAIT_L
#undef PG8_BAR
#undef PG8_SCHED
}
}
#define LAS __attribute__((address_space(3)))
#define GAS __attribute__((address_space(1)))
using pg8::bf16_t; using pg8::bf16x8; using pg8::f32x4; using pg8::u32x4; using pg8::cvt_pk_bf16; using pg8::Unit; using pg8::HALF;
typedef short s16x4 __attribute__((ext_vector_type(4)));
typedef unsigned u32x2 __attribute__((ext_vector_type(2)));
constexpr int T = 16384, D = 2048, SEQ = 4096, NH = 16;
constexpr float RMS_EPS = 1e-6f;
constexpr float QSCALE = 0.12751743082459868f;
constexpr size_t MiB = 1u << 20;
constexpr size_t WS_SLOTA = 0, WS_WOUTB0 = 48 * MiB, WS_SCR = 56 * MiB, WS_BUF0 = 64 * MiB, WS_BUF1 = 128 * MiB, WS_K = 192 * MiB, WS_V = 256 * MiB, WS_Q = 320 * MiB;
constexpr size_t WS_END = 512 * MiB;
constexpr size_t WS_WA = 0;
constexpr size_t WS_SSQ = WS_SCR, WS_LSE = WS_SCR + 1 * MiB, WS_COS = WS_SCR + 3 * MiB, WS_SIN = WS_SCR + 4 * MiB;
constexpr size_t WS_WINA0 = WS_WA, WS_WINA1 = WS_WA + 16 * MiB, WS_WG0 = WS_WA + 32 * MiB, WS_WG1 = WS_WA + 34 * MiB, WS_WOUTA0 = WS_WA + 36 * MiB, WS_WOUTA1 = WS_WA + 44 * MiB;
constexpr size_t OUT_WINB1 = 64 * MiB, OUT_WOUTB1 = 96 * MiB;
constexpr size_t WS_WU = 440 * MiB;
constexpr int LDS_BYTES = 147456, LDS_BARST = 143360;
constexpr size_t WS_FLAGS = WS_SCR + 512 * 1024 + 3 * 16384;
constexpr size_t WS_BAR = WS_SCR + 512 * 1024;
constexpr int AT_KP = 272, AT_VP = 288, AT_VOFF = 256 * AT_KP;
static_assert(AT_VOFF + 256 * AT_VP <= 143360, "attention LDS");

__device__ __forceinline__ int tid_l() { int t = threadIdx.x; asm volatile("" : "+v"(t)); return t; }
__device__ __forceinline__ float bf_lo(unsigned w) { return __uint_as_float(w << 16); }
__device__ __forceinline__ float bf_hi(unsigned w) { return __uint_as_float(w & 0xffff0000u); }
__device__ __forceinline__ float silu_f(float v) { return v * __builtin_amdgcn_rcpf(1.0f + __builtin_amdgcn_exp2f(-1.44269504089f * v)); }

struct EpiInA {
    static constexpr bool PERM = true, AFTER_DRAIN = false;
    const float* ssq; bf16_t* u; bf16_t* sg;
    __device__ __forceinline__ void operator()(const f32x4 (&acc)[2][2][4][2], const Unit& un, int wr, int wc, int fr, int fq) const {
        const int row0 = un.pm * 256 + wr * 64 + fr; const bool gate = un.pn >= 8;
        bf16_t* base = gate ? sg : u; const int col0 = (un.pn & 7) * 256 + wc * 32 + 8 * fq;
        float inv[2][4];
#pragma unroll
        for (int ai = 0; ai < 2; ++ai)
#pragma unroll
            for (int m = 0; m < 4; ++m) inv[ai][m] = ssq[row0 + ai * HALF + m * 16];
#pragma unroll
        for (int ai = 0; ai < 2; ++ai)
#pragma unroll
            for (int m = 0; m < 4; ++m) inv[ai][m] = rsqrtf(inv[ai][m] * (1.0f / D) + RMS_EPS);
#pragma unroll
        for (int ai = 0; ai < 2; ++ai)
#pragma unroll
            for (int m = 0; m < 4; ++m) { const int row = row0 + ai * HALF + m * 16; const float iv = inv[ai][m];
                bf16_t* rowp = base + (size_t)row * D + col0;
#pragma unroll
                for (int bj = 0; bj < 2; ++bj) { f32x4 v0 = acc[ai][bj][m][0] * iv, v1 = acc[ai][bj][m][1] * iv;
                    if (gate) {
#pragma unroll
                        for (int j = 0; j < 4; ++j) { v0[j] = silu_f(v0[j]); v1[j] = silu_f(v1[j]); } }
                    u32x4 w; w.x = cvt_pk_bf16(v0[0], v0[1]); w.y = cvt_pk_bf16(v0[2], v0[3]); w.z = cvt_pk_bf16(v1[0], v1[1]); w.w = cvt_pk_bf16(v1[2], v1[3]);
                    *(u32x4*)(rowp + bj * HALF) = w; } }
    }
};
struct EpiFold {
    static constexpr bool PERM = true, AFTER_DRAIN = false;
    bf16_t* W0; size_t layer_stride;
    __device__ __forceinline__ void operator()(const f32x4 (&acc)[2][2][4][2], const Unit& un, int wr, int wc, int fr, int fq) const {
        const int row0 = (un.pm & 7) * 256 + wr * 64 + fr; const int col0 = un.pn * 256 + wc * 32 + 8 * fq; bf16_t* base = W0 + (size_t)(un.pm >> 3) * layer_stride;
#pragma unroll
        for (int ai = 0; ai < 2; ++ai)
#pragma unroll
            for (int m = 0; m < 4; ++m) { bf16_t* rowp = base + (size_t)(row0 + ai * HALF + m * 16) * D + col0;
#pragma unroll
                for (int bj = 0; bj < 2; ++bj) { const f32x4 v0 = acc[ai][bj][m][0], v1 = acc[ai][bj][m][1];
                    u32x4 w; w.x = cvt_pk_bf16(v0[0], v0[1]); w.y = cvt_pk_bf16(v0[2], v0[3]); w.z = cvt_pk_bf16(v1[0], v1[1]); w.w = cvt_pk_bf16(v1[2], v1[3]);
                    *(u32x4*)(rowp + bj * HALF) = w; } }
    }
};
struct EpiOut {
    static constexpr bool PERM = true, AFTER_DRAIN = false;
    const bf16_t* xin; bf16_t* xout; float* ssq_next;
    __device__ __forceinline__ void operator()(const f32x4 (&acc)[2][2][4][2], const Unit& un, int wr, int wc, int fr, int fq) const {
        const int row0 = un.pm * 256 + wr * 64 + fr; const int col0 = un.pn * 256 + wc * 32 + 8 * fq;
#pragma unroll
        for (int ai = 0; ai < 2; ++ai) { u32x4 xv[4][2];
#pragma unroll
            for (int m = 0; m < 4; ++m)
#pragma unroll
                for (int bj = 0; bj < 2; ++bj) xv[m][bj] = *(const u32x4*)(xin + (size_t)(row0 + ai * HALF + m * 16) * D + col0 + bj * HALF);
            __builtin_amdgcn_sched_barrier(0);
#pragma unroll
            for (int m = 0; m < 4; ++m) { const int row = row0 + ai * HALF + m * 16; const size_t off = (size_t)row * D + col0; float ss = 0.f;
#pragma unroll
                for (int bj = 0; bj < 2; ++bj) { const u32x4 x = xv[m][bj];
                    f32x4 a = acc[ai][bj][m][0], b = acc[ai][bj][m][1];
                    a[0] += bf_lo(x.x); a[1] += bf_hi(x.x); a[2] += bf_lo(x.y); a[3] += bf_hi(x.y); b[0] += bf_lo(x.z); b[1] += bf_hi(x.z); b[2] += bf_lo(x.w); b[3] += bf_hi(x.w);
                    ss += (a[0] * a[0] + a[1] * a[1]) + (a[2] * a[2] + a[3] * a[3]) + (b[0] * b[0] + b[1] * b[1]) + (b[2] * b[2] + b[3] * b[3]);
                    u32x4 w; w.x = cvt_pk_bf16(a[0], a[1]); w.y = cvt_pk_bf16(a[2], a[3]); w.z = cvt_pk_bf16(b[0], b[1]); w.w = cvt_pk_bf16(b[2], b[3]);
                    *(u32x4*)(xout + off + bj * HALF) = w; }
                ss += __shfl_xor(ss, 16); ss += __shfl_xor(ss, 32);
                if (fq == 0) atomicAdd(ssq_next + row, ss); }
            __builtin_amdgcn_sched_barrier(0); }
    }
};
struct EpiInB {
    static constexpr bool PERM = true, AFTER_DRAIN = false;
    const float* ssq; const float* cosT; const float* sinT; bf16_t* Kb; bf16_t* Vb; bf16_t* Qb; bf16_t* sg; int kvt;
    __device__ __forceinline__ void operator()(const f32x4 (&acc)[2][2][4][2], const Unit& un, int wr, int wc, int fr, int fq) const {
        const int row0 = un.pm * 256 + wr * 64 + fr; int pn = un.pn; const int j0 = wc * 32 + 8 * fq; const int bb = un.pm >> 4;
        int kind;  bf16_t* base; float osc = 1.f; int head0;
        if (pn < kvt) { if (pn < 8) { kind = 0; base = Kb + (size_t)bb * NH * SEQ * 128; head0 = 2 * pn; } else { kind = 1; base = Vb + (size_t)bb * NH * SEQ * 128; head0 = 2 * (pn - 8); } }
        else { pn -= kvt; if (pn < 24) { kind = 0; const int g = pn >> 3; base = Qb + (size_t)(g * 4 + bb) * NH * SEQ * 128; head0 = 2 * (pn & 7); osc = QSCALE; } else { kind = 2; base = sg; head0 = 0; pn -= 24; } }
        float inv[2][4];
#pragma unroll
        for (int ai = 0; ai < 2; ++ai)
#pragma unroll
            for (int m = 0; m < 4; ++m) inv[ai][m] = ssq[row0 + ai * HALF + m * 16];
        if (kind == 0) {
            const int f0 = j0 & 63; bf16_t* hb = base + (size_t)(head0 + (j0 >> 6)) * SEQ * 128 + f0;
            f32x4 cs[2][4];
#define EPI_LDCS(buf, gi) do { const int s_ = (row0 + ((gi) >> 2) * HALF + ((gi) & 3) * 16) & (SEQ - 1); const float* cp_ = cosT + s_ * 64 + f0; const float* sp_ = sinT + s_ * 64 + f0; \
                cs[buf][0] = *(const f32x4*)cp_; cs[buf][1] = *(const f32x4*)(cp_ + 4); cs[buf][2] = *(const f32x4*)sp_; cs[buf][3] = *(const f32x4*)(sp_ + 4); } while (0)
            EPI_LDCS(0, 0);
#pragma unroll
            for (int gi = 0; gi < 8; ++gi) { const int ai = gi >> 2, m = gi & 3;
                if (gi + 1 < 8) EPI_LDCS((gi + 1) & 1, gi + 1);
                const int row = row0 + ai * HALF + m * 16; const float iv = rsqrtf(inv[ai][m] * (1.0f / D) + RMS_EPS) * osc; const int s = row & (SEQ - 1);
                u32x4 w1, w2;
#pragma unroll
                for (int n = 0; n < 2; ++n) { const f32x4 c = cs[gi & 1][n], sn = cs[gi & 1][2 + n];
                    const f32x4 x1 = acc[ai][0][m][n] * iv, x2 = acc[ai][1][m][n] * iv;
                    const f32x4 o1 = x1 * c - x2 * sn, o2 = x2 * c + x1 * sn;
                    if (n == 0) { w1.x = cvt_pk_bf16(o1[0], o1[1]); w1.y = cvt_pk_bf16(o1[2], o1[3]); w2.x = cvt_pk_bf16(o2[0], o2[1]); w2.y = cvt_pk_bf16(o2[2], o2[3]); }
                    else        { w1.z = cvt_pk_bf16(o1[0], o1[1]); w1.w = cvt_pk_bf16(o1[2], o1[3]); w2.z = cvt_pk_bf16(o2[0], o2[1]); w2.w = cvt_pk_bf16(o2[2], o2[3]); } }
                bf16_t* rowp = hb + (size_t)s * 128;
                *(u32x4*)rowp = w1; *(u32x4*)(rowp + 64) = w2; }
#undef EPI_LDCS
        } else if (kind == 1) {
#pragma unroll
            for (int ai = 0; ai < 2; ++ai)
#pragma unroll
                for (int m = 0; m < 4; ++m) { const int row = row0 + ai * HALF + m * 16; const float iv = rsqrtf(inv[ai][m] * (1.0f / D) + RMS_EPS); const int s = row & (SEQ - 1);
#pragma unroll
                    for (int bj = 0; bj < 2; ++bj) { const f32x4 v0 = acc[ai][bj][m][0] * iv, v1 = acc[ai][bj][m][1] * iv;
                        u32x4 w; w.x = cvt_pk_bf16(v0[0], v0[1]); w.y = cvt_pk_bf16(v0[2], v0[3]); w.z = cvt_pk_bf16(v1[0], v1[1]); w.w = cvt_pk_bf16(v1[2], v1[3]);
                        *(u32x4*)(base + ((size_t)(head0 + bj) * SEQ + s) * 128 + j0) = w; } }
        } else {
            const int col0 = pn * 256 + j0;
#pragma unroll
            for (int ai = 0; ai < 2; ++ai)
#pragma unroll
                for (int m = 0; m < 4; ++m) { const int row = row0 + ai * HALF + m * 16; const float iv = rsqrtf(inv[ai][m] * (1.0f / D) + RMS_EPS);
                    bf16_t* rowp = base + (size_t)row * D + col0;
#pragma unroll
                    for (int bj = 0; bj < 2; ++bj) { f32x4 v0 = acc[ai][bj][m][0] * iv, v1 = acc[ai][bj][m][1] * iv;
#pragma unroll
                        for (int j = 0; j < 4; ++j) { v0[j] = silu_f(v0[j]); v1[j] = silu_f(v1[j]); }
                        u32x4 w; w.x = cvt_pk_bf16(v0[0], v0[1]); w.y = cvt_pk_bf16(v0[2], v0[3]); w.z = cvt_pk_bf16(v1[0], v1[1]); w.w = cvt_pk_bf16(v1[2], v1[3]);
                        *(u32x4*)(rowp + bj * HALF) = w; } }
        }
    }
};
__device__ __forceinline__ void transpose_item(const float* W, int ldw, int scol0, const float* gvec, bf16_t* WT, int K, int drow0, LAS float* scr, int k0, int lane) {
    float tv[32]; const float* wp = W + (size_t)(k0 + (lane >> 5)) * ldw + scol0 + (lane & 31);
#pragma unroll
    for (int i = 0; i < 32; ++i) tv[i] = __builtin_nontemporal_load(wp + (size_t)(2 * i) * ldw);
    if (gvec) { const float* gp = gvec + k0 + (lane >> 5);
#pragma unroll
        for (int i = 0; i < 32; ++i) tv[i] *= gp[2 * i]; }
#pragma unroll
    for (int i = 0; i < 32; ++i) scr[(2 * i + (lane >> 5)) * 33 + (lane & 31)] = tv[i];
    asm volatile("s_waitcnt lgkmcnt(0)" ::: "memory");
    const int c = lane & 7;
#pragma unroll
    for (int j = 0; j < 4; ++j) { const int n = (lane >> 3) + 8 * j; const LAS float* s = scr + (8 * c) * 33 + n;
        u32x4 o; o.x = cvt_pk_bf16(s[0 * 33], s[1 * 33]); o.y = cvt_pk_bf16(s[2 * 33], s[3 * 33]); o.z = cvt_pk_bf16(s[4 * 33], s[5 * 33]); o.w = cvt_pk_bf16(s[6 * 33], s[7 * 33]);
        *(u32x4*)(WT + (size_t)(drow0 + n) * K + k0 + 8 * c) = o; }
    asm volatile("s_waitcnt lgkmcnt(0)" ::: "memory");
}
__device__ __forceinline__ void convert_job(const float* W, int ldw, int scol_base, int K, int N, const float* gvec, bf16_t* WT, bool perm, int gw, int NGW, LAS float* scr, int lane) {
    const int nblk = N / 32, items = (K / 64) * nblk;
    for (int it = gw; it < items; it += NGW) { const int kb = it / nblk, nb = it % nblk; const int n0 = 32 * nb; int sc = n0;
        if (perm) { const int t = n0 & 255, blk = t >> 6; sc = (n0 & ~255) + (blk == 1 ? t + 64 : (blk == 2 ? t - 64 : t)); }
        transpose_item(W, ldw, scol_base + sc, gvec, WT, K, n0, scr, 64 * kb, lane); }
}

struct Params { const float* in[13]; float* out; unsigned char* ws; int ph_lo, ph_hi; };

__device__ __forceinline__ void prologue(const Params& p, LAS unsigned char* lds, int vcu, int G) {
    const int tid = tid_l(), lane = tid & 63, wave = tid >> 6; unsigned char* ws = p.ws; unsigned char* ow = (unsigned char*)p.out;
    LAS float* scr = (LAS float*)(lds + wave * 16384);
    const int gw = vcu * 8 + wave, NGW = G * 8;
    const float* norm_a = p.in[1]; const float* w_in_a = p.in[2]; const float* w_grp_a = p.in[3]; const float* w_out_a = p.in[5];
    { const float* x = p.in[0]; bf16_t* xb = (bf16_t*)(ws + WS_BUF0); float* ssq = (float*)(ws + WS_SSQ);
      for (int row = gw; row < T; row += NGW) { const f32x4* xr = (const f32x4*)(x + (size_t)row * D) + lane; float s = 0.f; u32x2* o = (u32x2*)(xb + (size_t)row * D) + lane;
#pragma unroll
          for (int j = 0; j < 8; ++j) { const f32x4 v = __builtin_nontemporal_load(xr + 64 * j); s += (v[0] * v[0] + v[1] * v[1]) + (v[2] * v[2] + v[3] * v[3]); u32x2 w; w.x = cvt_pk_bf16(v[0], v[1]); w.y = cvt_pk_bf16(v[2], v[3]); o[64 * j] = w; }
#pragma unroll
          for (int o2 = 1; o2 < 64; o2 <<= 1) s += __shfl_xor(s, o2);
          if (lane == 0) ssq[row] = s; }
      for (int i = (vcu * 512 + tid); i < 4 * T; i += G * 512) ssq[T + i] = 0.f;
    }
    { float* cosT = (float*)(ws + WS_COS); float* sinT = (float*)(ws + WS_SIN);
      for (int i = (vcu * 512 + tid); i < SEQ * 64; i += G * 512) { const int s = i >> 6, f = i & 63;
          const float inv_freq = (float)exp2(-(double)f * (13.287712379549449 / 64.0));
          const float ang = (float)s * inv_freq; double t = (double)ang * 0.15915494309189535; t -= floor(t); const float tf = (float)t;
          cosT[i] = __builtin_amdgcn_cosf(tf); sinT[i] = __builtin_amdgcn_sinf(tf); } }
    for (int i = 0; i < 2; ++i) {
        convert_job(w_in_a + (size_t)i * D * 2 * D, 2 * D, D, D, D, norm_a + i * D, (bf16_t*)(ow + (i ? WS_WINA1 : WS_WINA0)) + (size_t)D * D, false, gw, NGW, scr, lane);
        { const float* wsrc = w_in_a + (size_t)i * D * 2 * D; const float* gv = norm_a + i * D; bf16_t* wu = (bf16_t*)(ws + WS_WU) + (size_t)i * D * D;
          for (int it = vcu * 512 + tid; it < D * D / 8; it += G * 512) { const int k = it >> 8, c8 = (it & 255) * 8; const float gk = gv[k];
              const f32x4 a = __builtin_nontemporal_load((const f32x4*)(wsrc + (size_t)k * 2 * D + c8)) * gk, b = __builtin_nontemporal_load((const f32x4*)(wsrc + (size_t)k * 2 * D + c8 + 4)) * gk;
              u32x4 w; w.x = cvt_pk_bf16(a[0], a[1]); w.y = cvt_pk_bf16(a[2], a[3]); w.z = cvt_pk_bf16(b[0], b[1]); w.w = cvt_pk_bf16(b[2], b[3]);
              *(u32x4*)(wu + (size_t)k * D + c8) = w; } }
        convert_job(w_out_a + (size_t)i * D * D, D, 0, D, D, nullptr, (bf16_t*)(ow + (i ? WS_WOUTA1 : WS_WOUTA0)), false, gw, NGW, scr, lane);
    }
    {
      for (int it = gw; it < 1024; it += NGW) { const int mi = it >> 7, li = it & 127, kb = li >> 4, nb = li & 15; const int layer = mi >> 2, grp = mi & 3;
          bf16_t* dst = (bf16_t*)(ow + (layer ? WS_WG1 : WS_WG0)) + (size_t)grp * 512 * 512;
          transpose_item(w_grp_a + (size_t)mi * 512 * 512, 512, 32 * nb, nullptr, dst, 512, 32 * nb, scr, 64 * kb, lane); } }
}
__device__ __forceinline__ void convert_bweights(const Params& p, LAS unsigned char* lds, int lv, int LG) {
    const int tid = tid_l(), lane = tid & 63, wave = tid >> 6; unsigned char* ws = p.ws; unsigned char* ow = (unsigned char*)p.out;
    LAS float* scr = (LAS float*)(lds + wave * 16384); const int gw = lv * 8 + wave, NGW = LG * 8;
    const float* norm_kv = p.in[6]; const float* w_k = p.in[7]; const float* w_v = p.in[8]; const float* norm_b = p.in[9]; const float* w_in_b = p.in[10]; const float* w_out_b = p.in[11];
    bf16_t* sa = (bf16_t*)(ws + WS_SLOTA);
    convert_job(w_k, D, 0, D, D, norm_kv, sa, true, gw, NGW, scr, lane);
    convert_job(w_v, D, 0, D, D, norm_kv, sa + (size_t)D * D, false, gw, NGW, scr, lane);
    convert_job(w_in_b, 4 * D, 0, D, 3 * D, norm_b, sa + (size_t)2 * D * D, true, gw, NGW, scr, lane);
    convert_job(w_in_b, 4 * D, 3 * D, D, D, norm_b, sa + (size_t)5 * D * D, false, gw, NGW, scr, lane);
    convert_job(w_out_b, D, 0, D, D, nullptr, (bf16_t*)(ws + WS_WOUTB0), false, gw, NGW, scr, lane);
    bf16_t* sb = (bf16_t*)(ow + OUT_WINB1);
    convert_job(w_in_b + (size_t)D * 4 * D, 4 * D, 0, D, 3 * D, norm_b + D, sb, true, gw, NGW, scr, lane);
    convert_job(w_in_b + (size_t)D * 4 * D, 4 * D, 3 * D, D, D, norm_b + D, sb + (size_t)3 * D * D, false, gw, NGW, scr, lane);
    convert_job(w_out_b + (size_t)D * D, D, 0, D, D, nullptr, (bf16_t*)(ow + OUT_WOUTB1), false, gw, NGW, scr, lane);
}

__device__ __forceinline__ void pool_phase(const bf16_t* __restrict__ z, const bf16_t* __restrict__ sg, const float* __restrict__ scale, bf16_t* __restrict__ h, int lv, int LG, int half) {
    const int nthr = LG * 512;
    for (int it0 = lv * 512 + tid_l(); it0 < 256 * 256; it0 += nthr) { const int item = half * 256 * 256 + it0;
        const int cc = item & 255, seg = item >> 8; const int t0 = seg * 32, s0 = t0 & (SEQ - 1); const int w = 2 << (cc >> 6);
        const bf16_t* up = z + (size_t)t0 * D + cc * 8; const bf16_t* gp = sg + (size_t)t0 * D + cc * 8; bf16_t* pp = h + (size_t)t0 * D + cc * 8;
        const f32x4 sc0 = *(const f32x4*)(scale + cc * 8), sc1 = *(const f32x4*)(scale + cc * 8 + 4);
        const float scv[8] = {sc0[0], sc0[1], sc0[2], sc0[3], sc1[0], sc1[1], sc1[2], sc1[3]};
        float sum[8];
#pragma unroll
        for (int j = 0; j < 8; ++j) sum[j] = 0.f;
        if (s0 > 0) for (int k = 1; k < w; ++k) { const u32x4 v = *(const u32x4*)(up - (size_t)k * D);
            sum[0] += bf_lo(v.x); sum[1] += bf_hi(v.x); sum[2] += bf_lo(v.y); sum[3] += bf_hi(v.y); sum[4] += bf_lo(v.z); sum[5] += bf_hi(v.z); sum[6] += bf_lo(v.w); sum[7] += bf_hi(v.w); }
#pragma unroll 8
        for (int i = 0; i < 32; ++i) { const int s = s0 + i; const u32x4 v = *(const u32x4*)(up + (size_t)i * D), gq = *(const u32x4*)(gp + (size_t)i * D);
            float c[8] = {bf_lo(v.x), bf_hi(v.x), bf_lo(v.y), bf_hi(v.y), bf_lo(v.z), bf_hi(v.z), bf_lo(v.w), bf_hi(v.w)};
            const float gt[8] = {bf_lo(gq.x), bf_hi(gq.x), bf_lo(gq.y), bf_hi(gq.y), bf_lo(gq.z), bf_hi(gq.z), bf_lo(gq.w), bf_hi(gq.w)};
            const float rc = 1.0f / (float)((s + 1 < w) ? (s + 1) : w); float o[8];
#pragma unroll
            for (int j = 0; j < 8; ++j) { sum[j] += c[j]; o[j] = (sum[j] * rc - c[j]) * scv[j] * gt[j]; }
            u32x4 ov; ov.x = cvt_pk_bf16(o[0], o[1]); ov.y = cvt_pk_bf16(o[2], o[3]); ov.z = cvt_pk_bf16(o[4], o[5]); ov.w = cvt_pk_bf16(o[6], o[7]);
            *(u32x4*)(pp + (size_t)i * D) = ov;
            if (s - w + 1 >= 0) { const u32x4 r = *(const u32x4*)(up + (ptrdiff_t)(i - w + 1) * D);
                sum[0] -= bf_lo(r.x); sum[1] -= bf_hi(r.x); sum[2] -= bf_lo(r.y); sum[3] -= bf_hi(r.y); sum[4] -= bf_lo(r.z); sum[5] -= bf_hi(r.z); sum[6] -= bf_lo(r.w); sum[7] -= bf_hi(r.w); } }
    }
}

__device__ __forceinline__ void final_norm(const bf16_t* xb, float* out, const float* ssq, const float* gam, int lv, int LG, int half) {
    const int tidf = tid_l(); const int lane = tidf & 63, wave = tidf >> 6;
    for (int r0 = lv * 8 + wave; r0 < T / 2; r0 += LG * 8) { const int row = half * (T / 2) + r0; const float inv = rsqrtf(ssq[row] * (1.0f / D) + RMS_EPS); const u32x4* xr = (const u32x4*)(xb + (size_t)row * D) + lane; f32x4* orow = (f32x4*)(out + (size_t)row * D) + 2 * lane; const f32x4* gr = (const f32x4*)gam + 2 * lane;
#pragma unroll
        for (int j = 0; j < 4; ++j) { const u32x4 v = xr[64 * j]; const f32x4 g0 = gr[128 * j], g1 = gr[128 * j + 1];
            f32x4 a = (f32x4){bf_lo(v.x), bf_hi(v.x), bf_lo(v.y), bf_hi(v.y)}, b = (f32x4){bf_lo(v.z), bf_hi(v.z), bf_lo(v.w), bf_hi(v.w)};
            __builtin_nontemporal_store(a * inv * g0, orow + 128 * j); __builtin_nontemporal_store(b * inv * g1, orow + 128 * j + 1); } }
}

__device__ __forceinline__ s16x4 tr_read(unsigned addr) { s16x4 r; asm volatile("ds_read_b64_tr_b16 %0, %1" : "=&v"(r) : "v"(addr) : "memory"); return r; }
struct AUnit { int g, b, h, r, n; };
template <int PH> __device__ __forceinline__ AUnit attn_decode(int u, int half) {
    AUnit a; int bh;
    if (PH == 0) { const int k = u >> 7, x = (u >> 5) & 3, j = u & 31; a.g = 1 + (k & 1); bh = 32 * half + 4 * (k >> 1) + x; if (a.g == 1) { a.n = j & 7; a.r = j >> 3; } else { a.n = j & 1; a.r = j >> 1; } }
    else { a.g = 0; a.n = u & 31; a.r = 0; bh = 32 * half + (u >> 5); }
    a.b = bh >> 4; a.h = bh & 15; return a;
}
template <int IS_V> __device__ __forceinline__ void attn_dma(LAS unsigned char* tile, const bf16_t* src, const AUnit& a, int w, int lane) {
    const int dsh = 2 * a.g; const int rsub = lane >> 4, pc = lane & 15;
    const unsigned hbase = (unsigned)(((a.b * NH + a.h) * SEQ + a.r) * 256);
#pragma unroll
    for (int it = 0; it < 8; ++it) { const int row = 32 * w + 4 * it + rsub; int pk = (a.n - 1) * 128 + row; pk = pk < 0 ? 0 : pk;
        const int f = IS_V ? 2 * (row & 7) : (row & 15);
        const unsigned goff = hbase + ((unsigned)(pk * 256) << dsh) + 16u * (unsigned)(pc ^ f);
        __builtin_amdgcn_global_load_lds((const unsigned*)((const char*)src + (size_t)goff), (LAS unsigned*)(tile + (32 * w + 4 * it) * 256), 16, 0, 0); }
}
template <int OFF> __device__ __forceinline__ s16x4 tr_read_o(unsigned addr) { s16x4 r; asm volatile("ds_read_b64_tr_b16 %0, %1 offset:%2" : "=&v"(r) : "v"(addr), "i"(OFF) : "memory"); return r; }
template <int PH>
__device__ __forceinline__ void attn_phase(LAS unsigned char* lds, const bf16_t* Kb, const bf16_t* Vb, bf16_t* Qb, bf16_t* sg, float* lse, int vcu, int G, int half) {
    const int nunits = PH == 0 ? 2048 : 1024;
    int tid_ = threadIdx.x; asm volatile("" : "+v"(tid_));
    const int tid = tid_, w = __builtin_amdgcn_readfirstlane(tid >> 6), lane = tid & 63, ln = lane & 15, q = lane >> 4;
    const int i = 16 * w + ln;
    LAS unsigned char* Kt = lds; LAS unsigned char* Vt = lds + 65536;
    __syncthreads();
    for (int z = tid; z < 256; z += 512) *(LAS u32x4*)(Vt + 65536 + z * 16) = (u32x4){0u, 0u, 0u, 0u};
    const LAS unsigned char* kb4[4]; unsigned vb8[8];
    { const int k7 = (4 * q + (ln >> 2)) & 7;
#pragma unroll
      for (int c = 0; c < 4; ++c) kb4[c] = Kt + (16 * w + ln) * 256 + 16 * ((4 * c + q) ^ ln);
#pragma unroll
      for (int db = 0; db < 8; ++db) vb8[db] = (unsigned)(uintptr_t)Vt + (16 * w + 4 * q + (ln >> 2)) * 256 + 16 * ((ln & 3) >> 1) + 8 * (ln & 1) + 32 * (db ^ k7); }
    int u = vcu;
    if (u < nunits) {
        AUnit a = attn_decode<PH>(u, half);
        bf16x8 qn[4];
        attn_dma<0>(Kt, Kb, a, w, lane);
        { const int sq0 = ((a.n * 128 + i) << (2 * a.g)) + a.r; const bf16_t* qp0 = Qb + ((size_t)((a.g * 4 + a.b) * NH + a.h) * SEQ + sq0) * 128;
#pragma unroll
          for (int c = 0; c < 4; ++c) qn[c] = *(const bf16x8*)(qp0 + 32 * c + 8 * q); }
        for (;;) {
            const int dsh = 2 * a.g, n = a.n, g = a.g, h = a.h;
            const int sq = ((n * 128 + i) << dsh) + a.r; const size_t qrow = (size_t)(a.b * SEQ + sq);
            bf16_t* qp = Qb + ((size_t)((g * 4 + a.b) * NH + h) * SEQ + sq) * 128;
            asm volatile("s_waitcnt vmcnt(0)" ::: "memory");
            __syncthreads();
            attn_dma<1>(Vt, Vb, a, w, lane);
            bf16x8 qf[4];
#pragma unroll
            for (int c = 0; c < 4; ++c) qf[c] = qn[c];
            const int un = u + G; const bool has_next = un < nunits; AUnit an = a;
            if (has_next) an = attn_decode<PH>(un, half);
            f32x4 s[10];
            { bf16x8 kf[2][4];
#define AT_LOADK(buf, jt_) do { _Pragma("unroll") for (int c = 0; c < 4; ++c) kf[buf][c] = *(const LAS bf16x8*)(kb4[c] + 4096 * (jt_)); } while (0)
              AT_LOADK(0, 0);
#pragma unroll
              for (int jt = 0; jt < 9; ++jt) {
                  if (jt + 1 < 9) AT_LOADK((jt + 1) & 1, jt + 1);
                  __builtin_amdgcn_sched_barrier(0);
                  f32x4 acc = (f32x4){0.f, 0.f, 0.f, 0.f};
#pragma unroll
                  for (int c = 0; c < 4; ++c) acc = __builtin_amdgcn_mfma_f32_16x16x32_bf16(kf[jt & 1][c], qf[c], acc, 0, 0, 0);
                  s[jt] = acc;
                  __builtin_amdgcn_sched_barrier(0);
              }
#undef AT_LOADK
            }
            float mx = -1e30f; const int e0 = 4 * q - ln;
#pragma unroll
            for (int jt = 0; jt < 9; ++jt) { const int tl = w + jt; const bool tv = (tl < 16) && (n > 0 || tl >= 8);
#pragma unroll
                for (int j = 0; j < 4; ++j) { bool ok = tv; if (jt == 0) ok = ok && (e0 + j >= 0); if (jt == 8) ok = ok && (e0 + j <= 0);
                    const float v = ok ? s[jt][j] : -1e30f; s[jt][j] = v; mx = fmaxf(mx, v); } }
            mx = fmaxf(mx, __shfl_xor(mx, 16)); mx = fmaxf(mx, __shfl_xor(mx, 32));
            float l = 0.f;
#pragma unroll
            for (int jt = 0; jt < 9; ++jt)
#pragma unroll
                for (int j = 0; j < 4; ++j) { const float pv = __builtin_amdgcn_exp2f(s[jt][j] - mx); s[jt][j] = pv; l += pv; }
            s[9] = (f32x4){0.f, 0.f, 0.f, 0.f};
            l += __shfl_xor(l, 16); l += __shfl_xor(l, 32);
            u32x4 pbu[5];
#pragma unroll
            for (int ch = 0; ch < 5; ++ch) { pbu[ch].x = cvt_pk_bf16(s[2 * ch][0], s[2 * ch][1]); pbu[ch].y = cvt_pk_bf16(s[2 * ch][2], s[2 * ch][3]); pbu[ch].z = cvt_pk_bf16(s[2 * ch + 1][0], s[2 * ch + 1][1]); pbu[ch].w = cvt_pk_bf16(s[2 * ch + 1][2], s[2 * ch + 1][3]); }
            asm volatile("s_waitcnt vmcnt(0)" ::: "memory");
            __syncthreads();
            if (has_next) { attn_dma<0>(Kt, Kb, an, w, lane);
                const int sqn = ((an.n * 128 + i) << (2 * an.g)) + an.r; const bf16_t* qpn = Qb + ((size_t)((an.g * 4 + an.b) * NH + an.h) * SEQ + sqn) * 128;
#pragma unroll
                for (int c = 0; c < 4; ++c) qn[c] = *(const bf16x8*)(qpn + 32 * c + 8 * q); }
            u32x2 a1[8], a2[8], gg[8]; float L1 = 0.f, L2 = 0.f; bf16_t* gp = sg + qrow * D + h * 128;
            if (PH == 1) { const bf16_t* q1 = qp + (size_t)4 * NH * SEQ * 128; const bf16_t* q2 = qp + (size_t)8 * NH * SEQ * 128;
                L1 = lse[qrow * NH + h]; L2 = lse[(size_t)T * NH + qrow * NH + h];
#pragma unroll
                for (int db = 0; db < 8; ++db) { a1[db] = *(const u32x2*)(q1 + 16 * db + 4 * q); a2[db] = *(const u32x2*)(q2 + 16 * db + 4 * q); gg[db] = *(const u32x2*)(gp + 16 * db + 4 * q); } }
            f32x4 o[8];
#pragma unroll
            for (int db = 0; db < 8; ++db) o[db] = (f32x4){0.f, 0.f, 0.f, 0.f};
            { s16x4 lo[2][4], hi[2][4];
#define AT_TRISSUE(buf, st_) do { _Pragma("unroll") for (int d4 = 0; d4 < 4; ++d4) { lo[buf][d4] = tr_read_o<4096 * (2 * ((st_) >> 1))>(vb8[4 * ((st_) & 1) + d4]); hi[buf][d4] = tr_read_o<4096 * (2 * ((st_) >> 1) + 1)>(vb8[4 * ((st_) & 1) + d4]); } } while (0)
#define AT_PVSTEP(st_) do { \
                  if ((st_) + 1 < 10) { AT_TRISSUE(((st_) + 1) & 1, ((st_) + 1 < 10 ? (st_) + 1 : 9)); asm volatile("s_waitcnt lgkmcnt(8)" ::: "memory"); } \
                  else asm volatile("s_waitcnt lgkmcnt(0)" ::: "memory"); \
                  __builtin_amdgcn_sched_barrier(0); \
                  { union { u32x4 uu; bf16x8 v; } pb; pb.uu = pbu[(st_) >> 1]; \
                    _Pragma("unroll") for (int d4 = 0; d4 < 4; ++d4) { const bf16x8 vf = (bf16x8){lo[(st_) & 1][d4][0], lo[(st_) & 1][d4][1], lo[(st_) & 1][d4][2], lo[(st_) & 1][d4][3], hi[(st_) & 1][d4][0], hi[(st_) & 1][d4][1], hi[(st_) & 1][d4][2], hi[(st_) & 1][d4][3]}; \
                      o[4 * ((st_) & 1) + d4] = __builtin_amdgcn_mfma_f32_16x16x32_bf16(vf, pb.v, o[4 * ((st_) & 1) + d4], 0, 0, 0); } } \
                  __builtin_amdgcn_sched_barrier(0); } while (0)
              AT_TRISSUE(0, 0);
              AT_PVSTEP(0); AT_PVSTEP(1); AT_PVSTEP(2); AT_PVSTEP(3); AT_PVSTEP(4); AT_PVSTEP(5); AT_PVSTEP(6); AT_PVSTEP(7); AT_PVSTEP(8); AT_PVSTEP(9);
#undef AT_PVSTEP
#undef AT_TRISSUE
            }
            const float invl = 1.0f / l, L = mx + __builtin_amdgcn_logf(l);
            if (PH == 0) {
#pragma unroll
                for (int db = 0; db < 8; ++db) { u32x2 wv; wv.x = cvt_pk_bf16(o[db][0] * invl, o[db][1] * invl); wv.y = cvt_pk_bf16(o[db][2] * invl, o[db][3] * invl); *(u32x2*)(qp + 16 * db + 4 * q) = wv; }
                if (q == 0) lse[(size_t)(g - 1) * T * NH + qrow * NH + h] = L;
            } else {
                const float Lm = fmaxf(L, fmaxf(L1, L2));
                const float x0 = __builtin_amdgcn_exp2f(L - Lm), x1 = __builtin_amdgcn_exp2f(L1 - Lm), x2 = __builtin_amdgcn_exp2f(L2 - Lm); const float inv = 1.0f / (x0 + x1 + x2);
                const float w0 = x0 * inv * invl, w1 = x1 * inv, w2 = x2 * inv;
#pragma unroll
                for (int db = 0; db < 8; ++db) {
                    const float r0 = (w0 * o[db][0] + w1 * bf_lo(a1[db].x) + w2 * bf_lo(a2[db].x)) * bf_lo(gg[db].x), r1 = (w0 * o[db][1] + w1 * bf_hi(a1[db].x) + w2 * bf_hi(a2[db].x)) * bf_hi(gg[db].x);
                    const float r2 = (w0 * o[db][2] + w1 * bf_lo(a1[db].y) + w2 * bf_lo(a2[db].y)) * bf_lo(gg[db].y), r3 = (w0 * o[db][3] + w1 * bf_hi(a1[db].y) + w2 * bf_hi(a2[db].y)) * bf_hi(gg[db].y);
                    u32x2 wv; wv.x = cvt_pk_bf16(r0, r1); wv.y = cvt_pk_bf16(r2, r3); *(u32x2*)(gp + 16 * db + 4 * q) = wv; }
            }
            if (!has_next) break;
            u = un; a = an;
        }
    }
    __syncthreads();
}

#define XB_TMO      128
#define XB_XCNT(j)  (256  + 64 * (j))
#define XB_XSUB(j)  (1280 + 64 * (j))
#define XB_XGEN(j)  (2304 + 64 * (j))
#define XB_TOP      3328
#define XB_TOPGEN   3392
#define XCD_BAR_WORDS 3456
#define XB_SPIN_CAP (1u << 18)

__device__ __forceinline__ unsigned xb_ld(unsigned* p)              { return __hip_atomic_load(p, __ATOMIC_RELAXED, __HIP_MEMORY_SCOPE_AGENT); }
__device__ __forceinline__ unsigned xb_add(unsigned* p, unsigned v) { return __hip_atomic_fetch_add(p, v, __ATOMIC_RELAXED, __HIP_MEMORY_SCOPE_AGENT); }
__device__ __forceinline__ unsigned xb_xcc_id() { return (unsigned)__builtin_amdgcn_s_getreg((3 << 11) | 20) & 0xFu; }
#define XB_SPIN(cond, bar) do { unsigned _sp = 0; while (cond) { __builtin_amdgcn_s_sleep(1); \
    if ((++_sp & 255u) == 0u) { if (xb_ld(&(bar)[XB_TMO])) break; if (_sp > XB_SPIN_CAP) { atomicAdd(&(bar)[XB_TMO], 1u); break; } } } } while (0)

struct XcdBarrier {
    unsigned gsz;
    unsigned* bar; unsigned x;
    volatile LAS unsigned* st;
};

__device__ __forceinline__ XcdBarrier xcd_barrier_post(unsigned* bar, volatile LAS unsigned* st, unsigned gsz) {
    XcdBarrier b; b.gsz = gsz; b.bar = bar; b.x = xb_xcc_id(); b.st = st;
    if (threadIdx.x == 0) (void)xb_add(&bar[XB_XCNT(b.x)], 1u);
    return b;
}
__device__ __forceinline__ void xcd_barrier_complete(unsigned* bar, unsigned x, unsigned& nloc, unsigned& nx, unsigned G) {
    unsigned sum, cnt, mine, sp = 0u;
    for (;;) {
        sum = 0u; cnt = 0u; mine = 0u;
#pragma unroll
        for (unsigned j = 0; j < 16; ++j) { const unsigned c = xb_ld(&bar[XB_XCNT(j)]); sum += c; cnt += (c > 0u) ? 1u : 0u; mine = (j == x) ? c : mine; }
        if (sum == G) break;
        __builtin_amdgcn_s_sleep(1);
        if ((++sp & 255u) == 0u) { if (xb_ld(&bar[XB_TMO])) break; if (sp > XB_SPIN_CAP) { atomicAdd(&bar[XB_TMO], 1u); break; } }
    }
    nloc = mine > 0u ? mine : 1u; nx = cnt > 0u ? cnt : 1u;
}

__device__ __forceinline__ void xcd_barrier(const XcdBarrier& b) {
    asm volatile("s_waitcnt vmcnt(0)" ::: "memory");
    __syncthreads();
    if (threadIdx.x == 0) {
        unsigned* bar = b.bar;
        __builtin_amdgcn_s_waitcnt(0);
        unsigned nloc = b.st[0], nx = b.st[1];
        if (nloc == 0u) { xcd_barrier_complete(bar, b.x, nloc, nx, b.gsz); b.st[0] = nloc; b.st[1] = nx; }
        const unsigned old = xb_add(&bar[XB_XSUB(b.x)], 1u);
        const unsigned gen = old / nloc;
        if (old + 1u == (gen + 1u) * nloc) {
            __builtin_amdgcn_fence(__ATOMIC_RELEASE, "agent");
            asm volatile("s_waitcnt vmcnt(0)" ::: "memory");
            const unsigned og = xb_add(&bar[XB_TOP], 1u);
            const unsigned tg = og / nx;
            if (og + 1u == (tg + 1u) * nx) xb_add(&bar[XB_TOPGEN], 1u);
            else XB_SPIN(xb_ld(&bar[XB_TOPGEN]) == tg, bar);
            __builtin_amdgcn_fence(__ATOMIC_ACQUIRE, "agent");
            xb_add(&bar[XB_XGEN(b.x)], 1u);
            asm volatile("s_waitcnt vmcnt(0)" ::: "memory");
        } else {
            XB_SPIN(xb_ld(&bar[XB_XGEN(b.x)]) == gen, bar);
            __builtin_amdgcn_fence(__ATOMIC_ACQUIRE, "agent");
            asm volatile("s_waitcnt vmcnt(0)" ::: "memory");
        }
    }
    __syncthreads();
}

__device__ __forceinline__ void flag_set(unsigned* f) { __hip_atomic_store(f, 1u, __ATOMIC_RELEASE, __HIP_MEMORY_SCOPE_AGENT); }
__device__ __forceinline__ void flag_wait(unsigned* f) {
    if (threadIdx.x == 0) { unsigned sp = 0u;
        while (__hip_atomic_load(f, __ATOMIC_RELAXED, __HIP_MEMORY_SCOPE_AGENT) == 0u) { __builtin_amdgcn_s_sleep(4); if (++sp > (1u << 22)) break; }
        __builtin_amdgcn_fence(__ATOMIC_ACQUIRE, "agent"); asm volatile("s_waitcnt vmcnt(0)" ::: "memory"); }
    __syncthreads();
}
__global__ void __launch_bounds__(512, 2) mega(Params p) {
    extern __shared__ __attribute__((aligned(16))) unsigned char lds_raw[];
    LAS unsigned char* lds = (LAS unsigned char*)lds_raw;
    cg::grid_group grid = cg::this_grid();
    const int G = gridDim.x, bx = blockIdx.x; const int vcu = (bx % 8) * (G / 8) + bx / 8;
    const int half = (bx % 8) >> 2, LG = G / 2, xq = bx % 4, idx = bx / 8;
    const int lv = xq * (G / 8) + idx;
    const int cl = 8 * (idx >> 1) + 2 * xq + (idx & 1);
    unsigned char* ws = p.ws; unsigned char* ow = (unsigned char*)p.out;
    float* ssq = (float*)(ws + WS_SSQ); float* lse = (float*)(ws + WS_LSE); const float* cosT = (const float*)(ws + WS_COS); const float* sinT = (const float*)(ws + WS_SIN);
    bf16_t* Kb = (bf16_t*)(ws + WS_K); bf16_t* Vb = (bf16_t*)(ws + WS_V); bf16_t* Qb = (bf16_t*)(ws + WS_Q);
    unsigned* flagB = (unsigned*)(ws + WS_FLAGS); unsigned* flagA = flagB + 64; unsigned* flagD = flagB + 128;
    if (threadIdx.x == 0) { volatile LAS unsigned* st = (volatile LAS unsigned*)(lds + LDS_BARST); st[0] = 0u; st[1] = 0u; st[2] = 0u; st[3] = 0u; }
    __syncthreads();
    XcdBarrier gbar = xcd_barrier_post((unsigned*)(ws + WS_BAR), (volatile LAS unsigned*)(lds + LDS_BARST), (unsigned)G);
    XcdBarrier hbar = xcd_barrier_post((unsigned*)(ws + WS_BAR) + 4096 * (1 + half), (volatile LAS unsigned*)(lds + LDS_BARST + 8), (unsigned)LG);
#define SEAM() xcd_barrier(hbar)
    prologue(p, lds, vcu, G); __syncthreads();
    xcd_barrier(gbar);
    unsigned* flagF = flagB + 192;
    if (half == 0) {
        pg8::Gemm g{(const bf16_t*)(ow + WS_WG0), (const bf16_t*)(ws + WS_WU), 2 * D, D, 512, 512, 0, D, 1}; pg8::StaticOrder S; S.init(2 * D, D, LG, cl);
        EpiFold E{(bf16_t*)(ow + WS_WINA0), (size_t)(WS_WINA1 - WS_WINA0) / 2}; pg8::gemm_phase<EpiFold, pg8::StaticOrder, true, true>(lds, g, S, E); SEAM();
        if (lv == 0 && threadIdx.x == 0) flag_set(flagF);
    } else {
        convert_bweights(p, lds, lv, LG); __syncthreads(); SEAM(); if (lv == 0 && threadIdx.x == 0) flag_set(flagB);
        flag_wait(flagF);
    }
#pragma unroll 1
    for (int layer = 0; layer < 2; ++layer) {
        bf16_t* xb_in = (bf16_t*)(ws + ((layer & 1) ? WS_BUF1 : WS_BUF0)); bf16_t* other = (bf16_t*)(ws + ((layer & 1) ? WS_BUF0 : WS_BUF1));
        bf16_t* zb = Kb; bf16_t* hb = Qb;
        { pg8::Gemm g{xb_in, (const bf16_t*)(ow + (layer ? WS_WINA1 : WS_WINA0)), T / 2, 2 * D, D, D, 0, D, 0}; pg8::HalfOrder S; S.init(T / 2, 2 * D, LG, cl); S.pmoff = 32 * half;
          EpiInA E{ssq + layer * T, zb, other};
          pg8::gemm_phase<EpiInA, pg8::HalfOrder, true, true>(lds, g, S, E); SEAM(); }
        { pool_phase(zb, other, p.in[4] + layer * D, hb, lv, LG, half); SEAM(); }
        { pg8::Gemm g{hb, (const bf16_t*)(ow + (layer ? WS_WOUTA1 : WS_WOUTA0)), T / 2, D, D, D, 0, D, 0}; pg8::HalfOrder S; S.init(T / 2, D, LG, cl); S.pmoff = 32 * half;
          EpiOut E{xb_in, other, ssq + (layer + 1) * T};
          pg8::gemm_phase<EpiOut, pg8::HalfOrder, true, true>(lds, g, S, E); SEAM(); }
    }
    if (half == 1) { if (lv == 0 && threadIdx.x == 0) flag_set(flagA); }
    else flag_wait(flagB);
#pragma unroll 1
    for (int lb = 0; lb < 2; ++lb) {
        const int layer = 2 + lb;
        bf16_t* xb_in = (bf16_t*)(ws + WS_BUF0); bf16_t* other = (bf16_t*)(ws + WS_BUF1);
        { const int N = lb == 0 ? 6 * D : 4 * D; pg8::Gemm g{xb_in, lb == 0 ? (const bf16_t*)(ws + WS_SLOTA) : (const bf16_t*)(ow + OUT_WINB1), T / 2, N, D, D, 0, D, 0}; pg8::HalfOrder S; S.init(T / 2, N, LG, cl); S.pmoff = 32 * half;
          EpiInB E{ssq + layer * T, cosT, sinT, Kb, Vb, Qb, other, lb == 0 ? 16 : 0};
          pg8::gemm_phase<EpiInB, pg8::HalfOrder, true, true>(lds, g, S, E); SEAM(); }
        { attn_phase<0>(lds, Kb, Vb, Qb, other, lse, lv, LG, half); SEAM(); }
        { attn_phase<1>(lds, Kb, Vb, Qb, other, lse, lv, LG, half); SEAM(); }
        { pg8::Gemm g{other, lb == 0 ? (const bf16_t*)(ws + WS_WOUTB0) : (const bf16_t*)(ow + OUT_WOUTB1), T / 2, D, D, D, 0, D, 0}; pg8::HalfOrder S; S.init(T / 2, D, LG, cl); S.pmoff = 32 * half;
          EpiOut E{xb_in, xb_in, ssq + (layer + 1) * T}; pg8::gemm_phase<EpiOut, pg8::HalfOrder, true, true>(lds, g, S, E); SEAM(); }
    }
    if (half == 0) { if (lv == 0 && threadIdx.x == 0) flag_set(flagD); flag_wait(flagA); }
    else flag_wait(flagD);
    final_norm((const bf16_t*)(ws + WS_BUF0), p.out, ssq + 4 * T, p.in[12], lv, LG, half);
    if (p.ph_hi == 12345) grid.sync();
#undef SEAM
}

extern "C" void kernel_launch(void* const* d_in, const int* in_sizes, int n_in, void* d_out, int out_size, void* d_ws, size_t ws_size, hipStream_t stream) {
    static int grid = 0;
    if (grid == 0) {
        if (n_in != 13 || out_size != T * D || ws_size < WS_END) { fprintf(stderr, "kernel_launch: unexpected shapes (n_in %d out %d ws %zu); nothing launched\n", n_in, out_size, ws_size); grid = -1; return; }
        int dev = 0, cus = 0, per_cu = 0;
        if (hipGetDevice(&dev) != hipSuccess || hipDeviceGetAttribute(&cus, hipDeviceAttributeMultiprocessorCount, dev) != hipSuccess) { grid = -1; return; }
        if (hipFuncSetAttribute((const void*)mega, hipFuncAttributeMaxDynamicSharedMemorySize, LDS_BYTES) != hipSuccess) { fprintf(stderr, "kernel_launch: hipFuncSetAttribute failed\n"); grid = -1; return; }
        if (hipOccupancyMaxActiveBlocksPerMultiprocessor(&per_cu, (const void*)mega, 512, LDS_BYTES) != hipSuccess || per_cu < 1) { fprintf(stderr, "kernel_launch: occupancy query gave %d\n", per_cu); per_cu = 1; }
        (void)hipGetLastError();
        grid = cus * per_cu;
        if (grid % 16 != 0) { fprintf(stderr, "kernel_launch: the two half-grids need a workgroup count that is a multiple of 16 (got %d); nothing launched\n", grid); grid = -1; return; }
    }
    if (grid < 0) return;
    Params p{};
    for (int i = 0; i < 13; ++i) p.in[i] = (const float*)d_in[i];
    p.out = (float*)d_out; p.ws = (unsigned char*)d_ws; p.ph_lo = 0; p.ph_hi = 1;
    if (hipMemsetAsync((unsigned char*)d_ws + WS_BAR, 0, (3 * 4096 + 256) * 4, stream) != hipSuccess) { fprintf(stderr, "kernel_launch: hipMemsetAsync failed; nothing launched\n"); return; }
    void* args[] = {&p};
    hipError_t e = hipLaunchCooperativeKernel((const void*)mega, dim3(grid), dim3(512), args, LDS_BYTES, stream);
    if (e != hipSuccess) fprintf(stderr, "kernel_launch: cooperative launch failed: %s (grid %d)\n", hipGetErrorString(e), grid);
}
```

```cpp
#include <hip/hip_runtime.h>
#include <hip/hip_cooperative_groups.h>
#include <cstdio>
#include <cstdint>
namespace cg = cooperative_groups;
namespace pg8 {
#define PG8_LAS __attribute__((address_space(3)))
typedef unsigned short bf16_t;
typedef short bf16x8 __attribute__((ext_vector_type(8)));
typedef float f32x4 __attribute__((ext_vector_type(4)));
typedef unsigned u32x4 __attribute__((ext_vector_type(4)));
constexpr int BM = 256, BK = 64, HALF = 128, HTB = HALF * BK * 2  , STAGE_BYTES = 8 * HTB, NXCD = 8, WGM = 8;

__host__ __device__ __forceinline__ int lds_byte(int r, int c) { const int st = (r >> 4) * 2 + (c >> 5), rr = r & 15, cc = c & 31, ob = rr * 64 + cc * 2; return st * 1024 + (ob ^ (((ob >> 9) & 1) << 5)); }
__host__ __device__ __forceinline__ void stage_rc(int b, int& R, int& C) { const int st = b / 1024, sb = b % 1024, swz = sb ^ (((sb >> 9) & 1) << 5); R = (st >> 1) * 16 + swz / 64; C = (st & 1) * 32 + (swz % 64) / 2; }
__host__ __device__ __forceinline__ int perm32(int rho) { const int n = rho >> 4, i = rho & 15; return 8 * (i >> 2) + 4 * n + (i & 3); }

struct Unit { int pm, pn; };
struct Gemm { const bf16_t* A; const bf16_t* Bt; int M, N, K, lda, agrp, ldb, bmode; };

struct StaticOrder {
    int nM, nN, nwg, G, c;
    __host__ __device__ void init(int M, int N, int G_, int c_) { nM = M / BM; nN = N / BM; nwg = nM * nN; G = G_; c = c_; }
    __host__ __device__ bool next(int i, Unit& u) const {
        const long L = (long)i * G + c; if (L >= nwg) return false;
        int wgid = (int)L; { const int q = nwg / NXCD, r = nwg % NXCD, xcd = wgid % NXCD, off = wgid / NXCD; wgid = (xcd < r ? xcd * (q + 1) : r * (q + 1) + (xcd - r) * q) + off; }
        const int nig = WGM * nN, gid = wgid / nig, fm = gid * WGM, gsz = (nM - fm) < WGM ? (nM - fm) : WGM;
        u.pm = fm + ((wgid % nig) % gsz); u.pn = (wgid % nig) / gsz; return true;
    }
    __device__ __forceinline__ void a_ready(const Unit&) const {}
    __device__ __forceinline__ void done(const Unit&) const {}
};

struct HalfOrder : StaticOrder { int pmoff;
    __host__ __device__ static int kind_perm(int p, int nN) {
        if (nN == 48) return p < 8 ? p : p < 16 ? p + 8 : p < 20 ? p - 8 : p < 24 ? p + 20 : p < 40 ? p : p < 44 ? p - 28 : p;
        if (nN == 32) return p < 12 ? p : p < 16 ? p + 12 : p < 28 ? p - 4 : p;
        if (nN == 16) return p < 4 ? p : p < 8 ? p + 4 : p < 12 ? p - 4 : p;
        return p; }
    __host__ __device__ bool next(int i, Unit& u) const { const bool r = StaticOrder::next(i, u); u.pm += pmoff; u.pn = kind_perm(u.pn, nN); return r; } };
__device__ __forceinline__ unsigned cvt_pk_bf16(float lo, float hi) { unsigned r; asm volatile("v_cvt_pk_bf16_f32 %0, %1, %2" : "=v"(r) : "v"(lo), "v"(hi)); return r; }
typedef float f32x2 __attribute__((ext_vector_type(2)));
template <class Epi, class Sched, bool ALIGN_EPI = false, bool SP2 = false>
__device__ __forceinline__ void gemm_phase(PG8_LAS unsigned char* lds, const Gemm g, const Sched& S, const Epi& E) {
    int tid_ = threadIdx.x; asm volatile("" : "+v"(tid_));
    const int tid = tid_, wid = __builtin_amdgcn_readfirstlane(tid >> 6), lane = tid & 63, wr = wid >> 2, wc = wid & 3, fr = lane & 15, fq = lane >> 4;
    const int K = g.K, nt = K / BK;
    unsigned voffA[2], voffB[2];
#pragma unroll
    for (int i = 0; i < 2; ++i) { int R, C; stage_rc(tid * 16 + i * 8192, R, C); const int Rb = Epi::PERM ? ((R & ~31) + perm32(R & 31)) : R;
        voffA[i] = (unsigned)(R * g.lda + C) * 2u; voffB[i] = (unsigned)(Rb * g.ldb + C) * 2u; }
    const size_t kstep = (size_t)(BK * 2);
    const size_t hstep = (size_t)HALF * g.ldb * 2;
    const size_t tstep = 2 * hstep;
    const size_t hstepA = (size_t)HALF * g.lda * 2, tstepA = 2 * hstepA;
    const unsigned ldsw = (unsigned)wid * 1024u;
    const int aoff = lds_byte(wr * 64 + fr, fq * 8), boff = lds_byte(wc * 32 + fr, fq * 8);
#define PG8_SA(b, h) (((b) * 2 + (h)) * HTB)
#define PG8_SB(b, h) ((4 + (b) * 2 + (h)) * HTB)
#define PG8_STAGE(bufoff, gbase, voff) do { _Pragma("unroll") for (int _i = 0; _i < 2; ++_i) \
        __builtin_amdgcn_global_load_lds((const unsigned*)((const char*)(gbase) + (voff)[_i]), (PG8_LAS unsigned*)(lds + (bufoff) + ldsw + _i * 8192), 16, 0, 0); } while (0)
#define PG8_LDA(dst, b, h) do { _Pragma("unroll") for (int m = 0; m < 4; ++m) _Pragma("unroll") for (int k = 0; k < 2; ++k) dst[m][k] = *(const PG8_LAS bf16x8*)(lds + PG8_SA(b, h) + aoff + m * 2048 + k * 1024); } while (0)
#define PG8_LDB(dst, b, h) do { _Pragma("unroll") for (int n = 0; n < 2; ++n) _Pragma("unroll") for (int k = 0; k < 2; ++k) dst[n][k] = *(const PG8_LAS bf16x8*)(lds + PG8_SB(b, h) + boff + n * 2048 + k * 1024); } while (0)
#define PG8_MMA(ai, bj, At, Bt) do { __builtin_amdgcn_s_setprio(1); _Pragma("unroll") for (int m = 0; m < 4; ++m) _Pragma("unroll") for (int n = 0; n < 2; ++n) _Pragma("unroll") for (int k = 0; k < 2; ++k) \
        acc[ai][bj][m][n] = __builtin_amdgcn_mfma_f32_16x16x32_bf16(Bt[n][k], At[m][k], acc[ai][bj][m][n], 0, 0, 0); __builtin_amdgcn_s_setprio(0); } while (0)
#define PG8_WAIT_V(n) asm volatile("s_waitcnt vmcnt(" #n ")" ::: "memory")
#define PG8_WAIT_L(n) asm volatile("s_waitcnt lgkmcnt(" #n ")" ::: "memory")
#define PG8_BAR __builtin_amdgcn_s_barrier()
#define PG8_SCHED __builtin_amdgcn_sched_barrier(0)
    Unit cur, nxt; int ui = 0;
    if (!S.next(0, cur)) return;
    f32x4 acc[2][2][4][2];
#pragma unroll
    for (int a = 0; a < 2; ++a)
#pragma unroll
        for (int b = 0; b < 2; ++b)
#pragma unroll
            for (int m = 0; m < 4; ++m)
#pragma unroll
                for (int n = 0; n < 2; ++n) acc[a][b][m][n] = (f32x4){0.f, 0.f, 0.f, 0.f};
    bf16x8 At[4][2], B0[2][2], B1[2][2];
    const char* cA = (const char*)g.A + (size_t)cur.pm * tstepA + (size_t)((cur.pn >> 1) * g.agrp) * 2; const char* cB = (const char*)g.Bt + (size_t)cur.pn * tstep + (g.bmode ? ((size_t)(cur.pm >> 3) * 2048 * 2048 + (size_t)((cur.pm >> 1) & 3) * 512) * 2 : (size_t)0);
    S.a_ready(cur);
    if constexpr (SP2) {
        PG8_STAGE(PG8_SB(0, 0), cB, voffB); PG8_STAGE(PG8_SB(0, 1), cB + hstep, voffB); PG8_STAGE(PG8_SA(0, 0), cA, voffA); PG8_STAGE(PG8_SA(0, 1), cA + hstepA, voffA);
        if (wr == 1) PG8_BAR;
        PG8_WAIT_V(2); PG8_BAR;
        PG8_STAGE(PG8_SB(1, 0), cB + kstep, voffB); PG8_STAGE(PG8_SA(1, 0), cA + kstep, voffA); PG8_STAGE(PG8_SB(1, 1), cB + hstep + kstep, voffB);
        PG8_WAIT_V(6); PG8_BAR;
    } else {
        PG8_STAGE(PG8_SB(0, 0), cB, voffB); PG8_STAGE(PG8_SA(0, 0), cA, voffA); PG8_STAGE(PG8_SB(0, 1), cB + hstep, voffB); PG8_STAGE(PG8_SA(0, 1), cA + hstepA, voffA);
        if (wr == 1) PG8_BAR;
        PG8_WAIT_V(4); PG8_BAR;
        PG8_STAGE(PG8_SB(1, 0), cB + kstep, voffB); PG8_STAGE(PG8_SA(1, 0), cA + kstep, voffA); PG8_STAGE(PG8_SB(1, 1), cB + hstep + kstep, voffB);
        PG8_WAIT_V(6); PG8_BAR;
    }
    for (;;) {
        const bool has_next = S.next(ui + 1, nxt);
        const char* nA = has_next ? (const char*)g.A + (size_t)nxt.pm * tstepA + (size_t)((nxt.pn >> 1) * g.agrp) * 2 : cA; const char* nB = has_next ? (const char*)g.Bt + (size_t)nxt.pn * tstep + (g.bmode ? ((size_t)(nxt.pm >> 3) * 2048 * 2048 + (size_t)((nxt.pm >> 1) & 3) * 512) * 2 : (size_t)0) : cB;
        for (int t = 0; t < nt; t += 2) {
            const bool last = (t == nt - 2);
            const char* a1 = cA + (size_t)(t + 1) * kstep;
            const char* a2 = last ? nA : cA + (size_t)(t + 2) * kstep; const char* b2 = last ? nB : cB + (size_t)(t + 2) * kstep;
            const char* a3 = a2 + kstep; const char* b3 = b2 + kstep;
            if (last && has_next) S.a_ready(nxt);
            if constexpr (SP2) {
            PG8_LDB(B0, 0, 0); PG8_LDB(B1, 0, 1); PG8_SCHED; PG8_LDA(At, 0, 0); PG8_STAGE(PG8_SA(1, 1), a1 + hstepA, voffA);
            PG8_WAIT_V(8); PG8_WAIT_L(0); PG8_BAR; PG8_MMA(0, 0, At, B0); PG8_MMA(0, 1, At, B1); PG8_BAR; PG8_SCHED;
            PG8_LDA(At, 0, 1); PG8_STAGE(PG8_SB(0, 0), b2, voffB); PG8_STAGE(PG8_SB(0, 1), b2 + hstep, voffB); PG8_STAGE(PG8_SA(0, 0), a2, voffA);
            PG8_WAIT_V(8); PG8_WAIT_L(0); PG8_BAR; PG8_MMA(1, 0, At, B0); PG8_MMA(1, 1, At, B1); PG8_BAR; PG8_SCHED;
            PG8_LDB(B0, 1, 0); PG8_LDB(B1, 1, 1); PG8_SCHED; PG8_LDA(At, 1, 0); PG8_STAGE(PG8_SA(0, 1), a2 + hstepA, voffA);
            PG8_WAIT_V(8); PG8_WAIT_L(0); PG8_BAR; PG8_MMA(0, 0, At, B0); PG8_MMA(0, 1, At, B1); PG8_BAR; PG8_SCHED;
            PG8_LDA(At, 1, 1); PG8_STAGE(PG8_SB(1, 0), b3, voffB); PG8_STAGE(PG8_SB(1, 1), b3 + hstep, voffB); PG8_STAGE(PG8_SA(1, 0), a3, voffA);
            PG8_WAIT_V(8); PG8_WAIT_L(0); PG8_BAR; PG8_MMA(1, 0, At, B0); PG8_MMA(1, 1, At, B1); PG8_BAR; PG8_SCHED;
            } else {
            PG8_LDB(B0, 0, 0); PG8_SCHED; PG8_LDA(At, 0, 0); PG8_STAGE(PG8_SA(1, 1), a1 + hstepA, voffA);
            PG8_WAIT_L(8); PG8_BAR; PG8_WAIT_L(0); PG8_MMA(0, 0, At, B0); PG8_BAR; PG8_SCHED;
            PG8_LDB(B1, 0, 1); PG8_STAGE(PG8_SB(0, 0), b2, voffB);
            PG8_BAR; PG8_WAIT_L(0); PG8_MMA(0, 1, At, B1); PG8_BAR;
            PG8_LDA(At, 0, 1); PG8_STAGE(PG8_SA(0, 0), a2, voffA);
            PG8_BAR; PG8_WAIT_L(0); PG8_MMA(1, 0, At, B0); PG8_BAR; PG8_SCHED;
            PG8_STAGE(PG8_SB(0, 1), b2 + hstep, voffB);
            PG8_WAIT_V(6); PG8_BAR; PG8_MMA(1, 1, At, B1); PG8_BAR;
            PG8_LDB(B0, 1, 0); PG8_SCHED; PG8_LDA(At, 1, 0); PG8_STAGE(PG8_SA(0, 1), a2 + hstepA, voffA);
            PG8_WAIT_L(8); PG8_BAR; PG8_WAIT_L(0); PG8_MMA(0, 0, At, B0); PG8_BAR; PG8_SCHED;
            PG8_LDB(B1, 1, 1); PG8_STAGE(PG8_SB(1, 0), b3, voffB);
            PG8_BAR; PG8_WAIT_L(0); PG8_MMA(0, 1, At, B1); PG8_BAR;
            PG8_LDA(At, 1, 1); PG8_STAGE(PG8_SA(1, 0), a3, voffA);
            PG8_BAR; PG8_WAIT_L(0); PG8_MMA(1, 0, At, B0); PG8_BAR; PG8_SCHED;
            PG8_STAGE(PG8_SB(1, 1), b3 + hstep, voffB);
            PG8_WAIT_V(6); PG8_BAR; PG8_MMA(1, 1, At, B1); PG8_BAR;
            }
        }
        if constexpr (ALIGN_EPI) { if (wr == 0) PG8_BAR; }
        if constexpr (!Epi::AFTER_DRAIN) { E(acc, cur, wr, wc, fr, fq); S.done(cur); }
        if (!has_next) break;
#pragma unroll
        for (int a = 0; a < 2; ++a)
#pragma unroll
            for (int b = 0; b < 2; ++b)
#pragma unroll
                for (int m = 0; m < 4; ++m)
#pragma unroll
                    for (int n = 0; n < 2; ++n) acc[a][b][m][n] = (f32x4){0.f, 0.f, 0.f, 0.f};
        cur = nxt; cA = nA; cB = nB; ++ui;
        if constexpr (ALIGN_EPI) { if (wr == 1) PG8_BAR; }
    }
    PG8_WAIT_V(0);
    if constexpr (!ALIGN_EPI) { if (wr == 0) PG8_BAR; }
    PG8_BAR;
    if constexpr (Epi::AFTER_DRAIN) { E.fused(acc, cur, wr, wc, fr, fq, lds, wid, lane); S.done(cur); }
#undef PG8_SA
#undef PG8_SB
#undef PG8_STAGE
#undef PG8_LDA
#undef PG8_LDB
#undef PG8_MMA
#undef PG8_WAIT_V
#undef PG8_WAIT_L
#undef PG8_BAR
#undef PG8_SCHED
}
}
#define LAS __attribute__((address_space(3)))
#define GAS __attribute__((address_space(1)))
using pg8::bf16_t; using pg8::bf16x8; using pg8::f32x4; using pg8::u32x4; using pg8::cvt_pk_bf16; using pg8::Unit; using pg8::HALF;
typedef short s16x4 __attribute__((ext_vector_type(4)));
typedef unsigned u32x2 __attribute__((ext_vector_type(2)));
constexpr int T = 16384, D = 2048, SEQ = 4096, NH = 16;
constexpr float RMS_EPS = 1e-6f;
constexpr float QSCALE = 0.12751743082459868f;
constexpr size_t MiB = 1u << 20;
constexpr size_t WS_SLOTA = 0, WS_WOUTB0 = 48 * MiB, WS_SCR = 56 * MiB, WS_BUF0 = 64 * MiB, WS_BUF1 = 128 * MiB, WS_K = 192 * MiB, WS_V = 256 * MiB, WS_Q = 320 * MiB;
constexpr size_t WS_END = 512 * MiB;
constexpr size_t WS_WA = 0;
constexpr size_t WS_SSQ = WS_SCR, WS_LSE = WS_SCR + 1 * MiB, WS_COS = WS_SCR + 3 * MiB, WS_SIN = WS_SCR + 4 * MiB;
constexpr size_t WS_WINA0 = WS_WA, WS_WINA1 = WS_WA + 16 * MiB, WS_WG0 = WS_WA + 32 * MiB, WS_WG1 = WS_WA + 34 * MiB, WS_WOUTA0 = WS_WA + 36 * MiB, WS_WOUTA1 = WS_WA + 44 * MiB;
constexpr size_t OUT_WINB1 = 64 * MiB, OUT_WOUTB1 = 96 * MiB;
constexpr size_t WS_WU = 440 * MiB;
constexpr int LDS_BYTES = 147456, LDS_BARST = 143360;
constexpr size_t WS_FLAGS = WS_SCR + 512 * 1024 + 3 * 16384;
constexpr size_t WS_BAR = WS_SCR + 512 * 1024;
constexpr int AT_KP = 272, AT_VP = 288, AT_VOFF = 256 * AT_KP;
static_assert(AT_VOFF + 256 * AT_VP <= 143360, "attention LDS");

__device__ __forceinline__ int tid_l() { int t = threadIdx.x; asm volatile("" : "+v"(t)); return t; }
__device__ __forceinline__ float bf_lo(unsigned w) { return __uint_as_float(w << 16); }
__device__ __forceinline__ float bf_hi(unsigned w) { return __uint_as_float(w & 0xffff0000u); }
__device__ __forceinline__ float silu_f(float v) { return v * __builtin_amdgcn_rcpf(1.0f + __builtin_amdgcn_exp2f(-1.44269504089f * v)); }

struct EpiInA {
    static constexpr bool PERM = true, AFTER_DRAIN = false;
    const float* ssq; bf16_t* u; bf16_t* sg;
    __device__ __forceinline__ void operator()(const f32x4 (&acc)[2][2][4][2], const Unit& un, int wr, int wc, int fr, int fq) const {
        const int row0 = un.pm * 256 + wr * 64 + fr; const bool gate = un.pn >= 8;
        bf16_t* base = gate ? sg : u; const int col0 = (un.pn & 7) * 256 + wc * 32 + 8 * fq;
        float inv[2][4];
#pragma unroll
        for (int ai = 0; ai < 2; ++ai)
#pragma unroll
            for (int m = 0; m < 4; ++m) inv[ai][m] = ssq[row0 + ai * HALF + m * 16];
#pragma unroll
        for (int ai = 0; ai < 2; ++ai)
#pragma unroll
            for (int m = 0; m < 4; ++m) inv[ai][m] = rsqrtf(inv[ai][m] * (1.0f / D) + RMS_EPS);
#pragma unroll
        for (int ai = 0; ai < 2; ++ai)
#pragma unroll
            for (int m = 0; m < 4; ++m) { const int row = row0 + ai * HALF + m * 16; const float iv = inv[ai][m];
                bf16_t* rowp = base + (size_t)row * D + col0;
#pragma unroll
                for (int bj = 0; bj < 2; ++bj) { f32x4 v0 = acc[ai][bj][m][0] * iv, v1 = acc[ai][bj][m][1] * iv;
                    if (gate) {
#pragma unroll
                        for (int j = 0; j < 4; ++j) { v0[j] = silu_f(v0[j]); v1[j] = silu_f(v1[j]); } }
                    u32x4 w; w.x = cvt_pk_bf16(v0[0], v0[1]); w.y = cvt_pk_bf16(v0[2], v0[3]); w.z = cvt_pk_bf16(v1[0], v1[1]); w.w = cvt_pk_bf16(v1[2], v1[3]);
                    *(u32x4*)(rowp + bj * HALF) = w; } }
    }
};
struct EpiFold {
    static constexpr bool PERM = true, AFTER_DRAIN = false;
    bf16_t* W0; size_t layer_stride;
    __device__ __forceinline__ void operator()(const f32x4 (&acc)[2][2][4][2], const Unit& un, int wr, int wc, int fr, int fq) const {
        const int row0 = (un.pm & 7) * 256 + wr * 64 + fr; const int col0 = un.pn * 256 + wc * 32 + 8 * fq; bf16_t* base = W0 + (size_t)(un.pm >> 3) * layer_stride;
#pragma unroll
        for (int ai = 0; ai < 2; ++ai)
#pragma unroll
            for (int m = 0; m < 4; ++m) { bf16_t* rowp = base + (size_t)(row0 + ai * HALF + m * 16) * D + col0;
#pragma unroll
                for (int bj = 0; bj < 2; ++bj) { const f32x4 v0 = acc[ai][bj][m][0], v1 = acc[ai][bj][m][1];
                    u32x4 w; w.x = cvt_pk_bf16(v0[0], v0[1]); w.y = cvt_pk_bf16(v0[2], v0[3]); w.z = cvt_pk_bf16(v1[0], v1[1]); w.w = cvt_pk_bf16(v1[2], v1[3]);
                    *(u32x4*)(rowp + bj * HALF) = w; } }
    }
};
struct EpiOut {
    static constexpr bool PERM = true, AFTER_DRAIN = false;
    const bf16_t* xin; bf16_t* xout; float* ssq_next;
    __device__ __forceinline__ void operator()(const f32x4 (&acc)[2][2][4][2], const Unit& un, int wr, int wc, int fr, int fq) const {
        const int row0 = un.pm * 256 + wr * 64 + fr; const int col0 = un.pn * 256 + wc * 32 + 8 * fq;
#pragma unroll
        for (int ai = 0; ai < 2; ++ai) { u32x4 xv[4][2];
#pragma unroll
            for (int m = 0; m < 4; ++m)
#pragma unroll
                for (int bj = 0; bj < 2; ++bj) xv[m][bj] = *(const u32x4*)(xin + (size_t)(row0 + ai * HALF + m * 16) * D + col0 + bj * HALF);
            __builtin_amdgcn_sched_barrier(0);
#pragma unroll
            for (int m = 0; m < 4; ++m) { const int row = row0 + ai * HALF + m * 16; const size_t off = (size_t)row * D + col0; float ss = 0.f;
#pragma unroll
                for (int bj = 0; bj < 2; ++bj) { const u32x4 x = xv[m][bj];
                    f32x4 a = acc[ai][bj][m][0], b = acc[ai][bj][m][1];
                    a[0] += bf_lo(x.x); a[1] += bf_hi(x.x); a[2] += bf_lo(x.y); a[3] += bf_hi(x.y); b[0] += bf_lo(x.z); b[1] += bf_hi(x.z); b[2] += bf_lo(x.w); b[3] += bf_hi(x.w);
                    ss += (a[0] * a[0] + a[1] * a[1]) + (a[2] * a[2] + a[3] * a[3]) + (b[0] * b[0] + b[1] * b[1]) + (b[2] * b[2] + b[3] * b[3]);
                    u32x4 w; w.x = cvt_pk_bf16(a[0], a[1]); w.y = cvt_pk_bf16(a[2], a[3]); w.z = cvt_pk_bf16(b[0], b[1]); w.w = cvt_pk_bf16(b[2], b[3]);
                    *(u32x4*)(xout + off + bj * HALF) = w; }
                ss += __shfl_xor(ss, 16); ss += __shfl_xor(ss, 32);
                if (fq == 0) atomicAdd(ssq_next + row, ss); }
            __builtin_amdgcn_sched_barrier(0); }
    }
};
struct EpiInB {
    static constexpr bool PERM = true, AFTER_DRAIN = false;
    const float* ssq; const float* cosT; const float* sinT; bf16_t* Kb; bf16_t* Vb; bf16_t* Qb; bf16_t* sg; int kvt;
    __device__ __forceinline__ void operator()(const f32x4 (&acc)[2][2][4][2], const Unit& un, int wr, int wc, int fr, int fq) const {
        const int row0 = un.pm * 256 + wr * 64 + fr; int pn = un.pn; const int j0 = wc * 32 + 8 * fq; const int bb = un.pm >> 4;
        int kind;  bf16_t* base; float osc = 1.f; int head0;
        if (pn < kvt) { if (pn < 8) { kind = 0; base = Kb + (size_t)bb * NH * SEQ * 128; head0 = 2 * pn; } else { kind = 1; base = Vb + (size_t)bb * NH * SEQ * 128; head0 = 2 * (pn - 8); } }
        else { pn -= kvt; if (pn < 24) { kind = 0; const int g = pn >> 3; base = Qb + (size_t)(g * 4 + bb) * NH * SEQ * 128; head0 = 2 * (pn & 7); osc = QSCALE; } else { kind = 2; base = sg; head0 = 0; pn -= 24; } }
        float inv[2][4];
#pragma unroll
        for (int ai = 0; ai < 2; ++ai)
#pragma unroll
            for (int m = 0; m < 4; ++m) inv[ai][m] = ssq[row0 + ai * HALF + m * 16];
        if (kind == 0) {
            const int f0 = j0 & 63; bf16_t* hb = base + (size_t)(head0 + (j0 >> 6)) * SEQ * 128 + f0;
            f32x4 cs[2][4];
#define EPI_LDCS(buf, gi) do { const int s_ = (row0 + ((gi) >> 2) * HALF + ((gi) & 3) * 16) & (SEQ - 1); const float* cp_ = cosT + s_ * 64 + f0; const float* sp_ = sinT + s_ * 64 + f0; \
                cs[buf][0] = *(const f32x4*)cp_; cs[buf][1] = *(const f32x4*)(cp_ + 4); cs[buf][2] = *(const f32x4*)sp_; cs[buf][3] = *(const f32x4*)(sp_ + 4); } while (0)
            EPI_LDCS(0, 0);
#pragma unroll
            for (int gi = 0; gi < 8; ++gi) { const int ai = gi >> 2, m = gi & 3;
                if (gi + 1 < 8) EPI_LDCS((gi + 1) & 1, gi + 1);
                const int row = row0 + ai * HALF + m * 16; const float iv = rsqrtf(inv[ai][m] * (1.0f / D) + RMS_EPS) * osc; const int s = row & (SEQ - 1);
                u32x4 w1, w2;
#pragma unroll
                for (int n = 0; n < 2; ++n) { const f32x4 c = cs[gi & 1][n], sn = cs[gi & 1][2 + n];
                    const f32x4 x1 = acc[ai][0][m][n] * iv, x2 = acc[ai][1][m][n] * iv;
                    const f32x4 o1 = x1 * c - x2 * sn, o2 = x2 * c + x1 * sn;
                    if (n == 0) { w1.x = cvt_pk_bf16(o1[0], o1[1]); w1.y = cvt_pk_bf16(o1[2], o1[3]); w2.x = cvt_pk_bf16(o2[0], o2[1]); w2.y = cvt_pk_bf16(o2[2], o2[3]); }
                    else        { w1.z = cvt_pk_bf16(o1[0], o1[1]); w1.w = cvt_pk_bf16(o1[2], o1[3]); w2.z = cvt_pk_bf16(o2[0], o2[1]); w2.w = cvt_pk_bf16(o2[2], o2[3]); } }
                bf16_t* rowp = hb + (size_t)s * 128;
                *(u32x4*)rowp = w1; *(u32x4*)(rowp + 64) = w2; }
#undef EPI_LDCS
        } else if (kind == 1) {
#pragma unroll
            for (int ai = 0; ai < 2; ++ai)
#pragma unroll
                for (int m = 0; m < 4; ++m) { const int row = row0 + ai * HALF + m * 16; const float iv = rsqrtf(inv[ai][m] * (1.0f / D) + RMS_EPS); const int s = row & (SEQ - 1);
#pragma unroll
                    for (int bj = 0; bj < 2; ++bj) { const f32x4 v0 = acc[ai][bj][m][0] * iv, v1 = acc[ai][bj][m][1] * iv;
                        u32x4 w; w.x = cvt_pk_bf16(v0[0], v0[1]); w.y = cvt_pk_bf16(v0[2], v0[3]); w.z = cvt_pk_bf16(v1[0], v1[1]); w.w = cvt_pk_bf16(v1[2], v1[3]);
                        *(u32x4*)(base + ((size_t)(head0 + bj) * SEQ + s) * 128 + j0) = w; } }
        } else {
            const int col0 = pn * 256 + j0;
#pragma unroll
            for (int ai = 0; ai < 2; ++ai)
#pragma unroll
                for (int m = 0; m < 4; ++m) { const int row = row0 + ai * HALF + m * 16; const float iv = rsqrtf(inv[ai][m] * (1.0f / D) + RMS_EPS);
                    bf16_t* rowp = base + (size_t)row * D + col0;
#pragma unroll
                    for (int bj = 0; bj < 2; ++bj) { f32x4 v0 = acc[ai][bj][m][0] * iv, v1 = acc[ai][bj][m][1] * iv;
#pragma unroll
                        for (int j = 0; j < 4; ++j) { v0[j] = silu_f(v0[j]); v1[j] = silu_f(v1[j]); }
                        u32x4 w; w.x = cvt_pk_bf16(v0[0], v0[1]); w.y = cvt_pk_bf16(v0[2], v0[3]); w.z = cvt_pk_bf16(v1[0], v1[1]); w.w = cvt_pk_bf16(v1[2], v1[3]);
                        *(u32x4*)(rowp + bj * HALF) = w; } }
        }
    }
};
__device__ __forceinline__ void transpose_item(const float* W, int ldw, int scol0, const float* gvec, bf16_t* WT, int K, int drow0, LAS float* scr, int k0, int lane) {
    float tv[32]; const float* wp = W + (size_t)(k0 + (lane >> 5)) * ldw + scol0 + (lane & 31);
#pragma unroll
    for (int i = 0; i < 32; ++i) tv[i] = __builtin_nontemporal_load(wp + (size_t)(2 * i) * ldw);
    if (gvec) { const float* gp = gvec + k0 + (lane >> 5);
#pragma unroll
        for (int i = 0; i < 32; ++i) tv[i] *= gp[2 * i]; }
#pragma unroll
    for (int i = 0; i < 32; ++i) scr[(2 * i + (lane >> 5)) * 33 + (lane & 31)] = tv[i];
    asm volatile("s_waitcnt lgkmcnt(0)" ::: "memory");
    const int c = lane & 7;
#pragma unroll
    for (int j = 0; j < 4; ++j) { const int n = (lane >> 3) + 8 * j; const LAS float* s = scr + (8 * c) * 33 + n;
        u32x4 o; o.x = cvt_pk_bf16(s[0 * 33], s[1 * 33]); o.y = cvt_pk_bf16(s[2 * 33], s[3 * 33]); o.z = cvt_pk_bf16(s[4 * 33], s[5 * 33]); o.w = cvt_pk_bf16(s[6 * 33], s[7 * 33]);
        *(u32x4*)(WT + (size_t)(drow0 + n) * K + k0 + 8 * c) = o; }
    asm volatile("s_waitcnt lgkmcnt(0)" ::: "memory");
}
__device__ __forceinline__ void convert_job(const float* W, int ldw, int scol_base, int K, int N, const float* gvec, bf16_t* WT, bool perm, int gw, int NGW, LAS float* scr, int lane) {
    const int nblk = N / 32, items = (K / 64) * nblk;
    for (int it = gw; it < items; it += NGW) { const int kb = it / nblk, nb = it % nblk; const int n0 = 32 * nb; int sc = n0;
        if (perm) { const int t = n0 & 255, blk = t >> 6; sc = (n0 & ~255) + (blk == 1 ? t + 64 : (blk == 2 ? t - 64 : t)); }
        transpose_item(W, ldw, scol_base + sc, gvec, WT, K, n0, scr, 64 * kb, lane); }
}

struct Params { const float* in[13]; float* out; unsigned char* ws; int ph_lo, ph_hi; };

__device__ __forceinline__ void prologue(const Params& p, LAS unsigned char* lds, int vcu, int G) {
    const int tid = tid_l(), lane = tid & 63, wave = tid >> 6; unsigned char* ws = p.ws; unsigned char* ow = (unsigned char*)p.out;
    LAS float* scr = (LAS float*)(lds + wave * 16384);
    const int gw = vcu * 8 + wave, NGW = G * 8;
    const float* norm_a = p.in[1]; const float* w_in_a = p.in[2]; const float* w_grp_a = p.in[3]; const float* w_out_a = p.in[5];
    { const float* x = p.in[0]; bf16_t* xb = (bf16_t*)(ws + WS_BUF0); float* ssq = (float*)(ws + WS_SSQ);
      for (int row = gw; row < T; row += NGW) { const f32x4* xr = (const f32x4*)(x + (size_t)row * D) + lane; float s = 0.f; u32x2* o = (u32x2*)(xb + (size_t)row * D) + lane;
#pragma unroll
          for (int j = 0; j < 8; ++j) { const f32x4 v = __builtin_nontemporal_load(xr + 64 * j); s += (v[0] * v[0] + v[1] * v[1]) + (v[2] * v[2] + v[3] * v[3]); u32x2 w; w.x = cvt_pk_bf16(v[0], v[1]); w.y = cvt_pk_bf16(v[2], v[3]); o[64 * j] = w; }
#pragma unroll
          for (int o2 = 1; o2 < 64; o2 <<= 1) s += __shfl_xor(s, o2);
          if (lane == 0) ssq[row] = s; }
      for (int i = (vcu * 512 + tid); i < 4 * T; i += G * 512) ssq[T + i] = 0.f;
    }
    { float* cosT = (float*)(ws + WS_COS); float* sinT = (float*)(ws + WS_SIN);
      for (int i = (vcu * 512 + tid); i < SEQ * 64; i += G * 512) { const int s = i >> 6, f = i & 63;
          const float inv_freq = (float)exp2(-(double)f * (13.287712379549449 / 64.0));
          const float ang = (float)s * inv_freq; double t = (double)ang * 0.15915494309189535; t -= floor(t); const float tf = (float)t;
          cosT[i] = __builtin_amdgcn_cosf(tf); sinT[i] = __builtin_amdgcn_sinf(tf); } }
    for (int i = 0; i < 2; ++i) {
        convert_job(w_in_a + (size_t)i * D * 2 * D, 2 * D, D, D, D, norm_a + i * D, (bf16_t*)(ow + (i ? WS_WINA1 : WS_WINA0)) + (size_t)D * D, false, gw, NGW, scr, lane);
        { const float* wsrc = w_in_a + (size_t)i * D * 2 * D; const float* gv = norm_a + i * D; bf16_t* wu = (bf16_t*)(ws + WS_WU) + (size_t)i * D * D;
          for (int it = vcu * 512 + tid; it < D * D / 8; it += G * 512) { const int k = it >> 8, c8 = (it & 255) * 8; const float gk = gv[k];
              const f32x4 a = __builtin_nontemporal_load((const f32x4*)(wsrc + (size_t)k * 2 * D + c8)) * gk, b = __builtin_nontemporal_load((const f32x4*)(wsrc + (size_t)k * 2 * D + c8 + 4)) * gk;
              u32x4 w; w.x = cvt_pk_bf16(a[0], a[1]); w.y = cvt_pk_bf16(a[2], a[3]); w.z = cvt_pk_bf16(b[0], b[1]); w.w = cvt_pk_bf16(b[2], b[3]);
              *(u32x4*)(wu + (size_t)k * D + c8) = w; } }
        convert_job(w_out_a + (size_t)i * D * D, D, 0, D, D, nullptr, (bf16_t*)(ow + (i ? WS_WOUTA1 : WS_WOUTA0)), false, gw, NGW, scr, lane);
    }
    {
      for (int it = gw; it < 1024; it += NGW) { const int mi = it >> 7, li = it & 127, kb = li >> 4, nb = li & 15; const int layer = mi >> 2, grp = mi & 3;
          bf16_t* dst = (bf16_t*)(ow + (layer ? WS_WG1 : WS_WG0)) + (size_t)grp * 512 * 512;
          transpose_item(w_grp_a + (size_t)mi * 512 * 512, 512, 32 * nb, nullptr, dst, 512, 32 * nb, scr, 64 * kb, lane); } }
}
__device__ __forceinline__ void convert_bweights(const Params& p, LAS unsigned char* lds, int lv, int LG) {
    const int tid = tid_l(), lane = tid & 63, wave = tid >> 6; unsigned char* ws = p.ws; unsigned char* ow = (unsigned char*)p.out;
    LAS float* scr = (LAS float*)(lds + wave * 16384); const int gw = lv * 8 + wave, NGW = LG * 8;
    const float* norm_kv = p.in[6]; const float* w_k = p.in[7]; const float* w_v = p.in[8]; const float* norm_b = p.in[9]; const float* w_in_b = p.in[10]; const float* w_out_b = p.in[11];
    bf16_t* sa = (bf16_t*)(ws + WS_SLOTA);
    convert_job(w_k, D, 0, D, D, norm_kv, sa, true, gw, NGW, scr, lane);
    convert_job(w_v, D, 0, D, D, norm_kv, sa + (size_t)D * D, false, gw, NGW, scr, lane);
    convert_job(w_in_b, 4 * D, 0, D, 3 * D, norm_b, sa + (size_t)2 * D * D, true, gw, NGW, scr, lane);
    convert_job(w_in_b, 4 * D, 3 * D, D, D, norm_b, sa + (size_t)5 * D * D, false, gw, NGW, scr, lane);
    convert_job(w_out_b, D, 0, D, D, nullptr, (bf16_t*)(ws + WS_WOUTB0), false, gw, NGW, scr, lane);
    bf16_t* sb = (bf16_t*)(ow + OUT_WINB1);
    convert_job(w_in_b + (size_t)D * 4 * D, 4 * D, 0, D, 3 * D, norm_b + D, sb, true, gw, NGW, scr, lane);
    convert_job(w_in_b + (size_t)D * 4 * D, 4 * D, 3 * D, D, D, norm_b + D, sb + (size_t)3 * D * D, false, gw, NGW, scr, lane);
    convert_job(w_out_b + (size_t)D * D, D, 0, D, D, nullptr, (bf16_t*)(ow + OUT_WOUTB1), false, gw, NGW, scr, lane);
}

__device__ __forceinline__ void pool_phase(const bf16_t* __restrict__ z, const bf16_t* __restrict__ sg, const float* __restrict__ scale, bf16_t* __restrict__ h, int lv, int LG, int half) {
    const int nthr = LG * 512;
    for (int it0 = lv * 512 + tid_l(); it0 < 256 * 256; it0 += nthr) { const int item = half * 256 * 256 + it0;
        const int cc = item & 255, seg = item >> 8; const int t0 = seg * 32, s0 = t0 & (SEQ - 1); const int w = 2 << (cc >> 6);
        const bf16_t* up = z + (size_t)t0 * D + cc * 8; const bf16_t* gp = sg + (size_t)t0 * D + cc * 8; bf16_t* pp = h + (size_t)t0 * D + cc * 8;
        const f32x4 sc0 = *(const f32x4*)(scale + cc * 8), sc1 = *(const f32x4*)(scale + cc * 8 + 4);
        const float scv[8] = {sc0[0], sc0[1], sc0[2], sc0[3], sc1[0], sc1[1], sc1[2], sc1[3]};
        float sum[8];
#pragma unroll
        for (int j = 0; j < 8; ++j) sum[j] = 0.f;
        if (s0 > 0) for (int k = 1; k < w; ++k) { const u32x4 v = *(const u32x4*)(up - (size_t)k * D);
            sum[0] += bf_lo(v.x); sum[1] += bf_hi(v.x); sum[2] += bf_lo(v.y); sum[3] += bf_hi(v.y); sum[4] += bf_lo(v.z); sum[5] += bf_hi(v.z); sum[6] += bf_lo(v.w); sum[7] += bf_hi(v.w); }
#pragma unroll 8
        for (int i = 0; i < 32; ++i) { const int s = s0 + i; const u32x4 v = *(const u32x4*)(up + (size_t)i * D), gq = *(const u32x4*)(gp + (size_t)i * D);
            float c[8] = {bf_lo(v.x), bf_hi(v.x), bf_lo(v.y), bf_hi(v.y), bf_lo(v.z), bf_hi(v.z), bf_lo(v.w), bf_hi(v.w)};
            const float gt[8] = {bf_lo(gq.x), bf_hi(gq.x), bf_lo(gq.y), bf_hi(gq.y), bf_lo(gq.z), bf_hi(gq.z), bf_lo(gq.w), bf_hi(gq.w)};
            const float rc = 1.0f / (float)((s + 1 < w) ? (s + 1) : w); float o[8];
#pragma unroll
            for (int j = 0; j < 8; ++j) { sum[j] += c[j]; o[j] = (sum[j] * rc - c[j]) * scv[j] * gt[j]; }
            u32x4 ov; ov.x = cvt_pk_bf16(o[0], o[1]); ov.y = cvt_pk_bf16(o[2], o[3]); ov.z = cvt_pk_bf16(o[4], o[5]); ov.w = cvt_pk_bf16(o[6], o[7]);
            *(u32x4*)(pp + (size_t)i * D) = ov;
            if (s - w + 1 >= 0) { const u32x4 r = *(const u32x4*)(up + (ptrdiff_t)(i - w + 1) * D);
                sum[0] -= bf_lo(r.x); sum[1] -= bf_hi(r.x); sum[2] -= bf_lo(r.y); sum[3] -= bf_hi(r.y); sum[4] -= bf_lo(r.z); sum[5] -= bf_hi(r.z); sum[6] -= bf_lo(r.w); sum[7] -= bf_hi(r.w); } }
    }
}

__device__ __forceinline__ void final_norm(const bf16_t* xb, float* out, const float* ssq, const float* gam, int lv, int LG, int half) {
    const int tidf = tid_l(); const int lane = tidf & 63, wave = tidf >> 6;
    for (int r0 = lv * 8 + wave; r0 < T / 2; r0 += LG * 8) { const int row = half * (T / 2) + r0; const float inv = rsqrtf(ssq[row] * (1.0f / D) + RMS_EPS); const u32x4* xr = (const u32x4*)(xb + (size_t)row * D) + lane; f32x4* orow = (f32x4*)(out + (size_t)row * D) + 2 * lane; const f32x4* gr = (const f32x4*)gam + 2 * lane;
#pragma unroll
        for (int j = 0; j < 4; ++j) { const u32x4 v = xr[64 * j]; const f32x4 g0 = gr[128 * j], g1 = gr[128 * j + 1];
            f32x4 a = (f32x4){bf_lo(v.x), bf_hi(v.x), bf_lo(v.y), bf_hi(v.y)}, b = (f32x4){bf_lo(v.z), bf_hi(v.z), bf_lo(v.w), bf_hi(v.w)};
            __builtin_nontemporal_store(a * inv * g0, orow + 128 * j); __builtin_nontemporal_store(b * inv * g1, orow + 128 * j + 1); } }
}

__device__ __forceinline__ s16x4 tr_read(unsigned addr) { s16x4 r; asm volatile("ds_read_b64_tr_b16 %0, %1" : "=&v"(r) : "v"(addr) : "memory"); return r; }
struct AUnit { int g, b, h, r, np; };
template <int PH> __device__ __forceinline__ AUnit attn_decode(int u, int half) {
    AUnit a; int bh;
    if (PH == 0) { const int k = u >> 7, x = (u >> 5) & 3, j = u & 31; bh = 32 * half + 4 * k + x; if (j < 16) { a.g = 1; a.r = j >> 2; a.np = j & 3; } else { a.g = 2; a.r = j - 16; a.np = 0; } }
    else { a.g = 0; a.np = u & 15; a.r = 0; bh = 32 * half + (u >> 4); }
    a.b = bh >> 4; a.h = bh & 15; return a;
}
__device__ __forceinline__ void attn_issue(u32x4 (&st)[12], const bf16_t* src, const AUnit& a, int tid) {
    const int dsh = 2 * a.g; const int c0 = tid >> 4, ch = tid & 15;
    const unsigned rstep = (unsigned)(32 * 256) << dsh;
    const unsigned voff0 = (unsigned)((((a.b * NH + a.h) * SEQ + a.r) * 128 + ch * 8) * 2) + (unsigned)((((2 * a.np - 1) * 128 + c0) * 256) << dsh);
#pragma unroll
    for (int it = 0; it < 12; ++it) { st[it] = (u32x4){0u, 0u, 0u, 0u};
        if (a.np > 0 || it >= 4) st[it] = *(const u32x4*)((const char*)src + (size_t)(voff0 + (unsigned)it * rstep)); }
}
template <int OFF> __device__ __forceinline__ s16x4 tr_read_o(unsigned addr) { s16x4 r; asm volatile("ds_read_b64_tr_b16 %0, %1 offset:%2" : "=&v"(r) : "v"(addr), "i"(OFF) : "memory"); return r; }
#define AT_RAWBAR() do { asm volatile("s_waitcnt lgkmcnt(0)" ::: "memory"); __builtin_amdgcn_s_barrier(); asm volatile("" ::: "memory"); } while (0)
template <int PH>
__device__ __forceinline__ void attn_phase(LAS unsigned char* lds, const bf16_t* Kb, const bf16_t* Vb, bf16_t* Qb, bf16_t* sg, float* lse, int vcu, int G, int half) {
    const int nunits = PH == 0 ? 1024 : 512;
    int tid_ = threadIdx.x; asm volatile("" : "+v"(tid_));
    const int tid = tid_, w = __builtin_amdgcn_readfirstlane(tid >> 6), lane = tid & 63, ln = lane & 15, q = lane >> 4;
    const int hh = w >> 2, jq = w & 3, T0 = 8 * hh + 2 * jq;
    const int e0 = 4 * q - ln;
    const LAS unsigned char* kb4[4]; unsigned vb8[8];
    { const int k7 = (4 * q + (ln >> 2)) & 7;
#pragma unroll
      for (int c = 0; c < 4; ++c) kb4[c] = lds + (16 * T0 + ln) * 256 + 16 * ((4 * c + q) ^ ln);
#pragma unroll
      for (int db = 0; db < 8; ++db) vb8[db] = (unsigned)(uintptr_t)lds + (16 * T0 + 4 * q + (ln >> 2)) * 256 + 16 * ((ln & 3) >> 1) + 8 * (ln & 1) + 32 * (db ^ k7); }
    LAS unsigned char* kst = lds + (tid >> 4) * 256 + 16 * ((tid & 15) ^ ((tid >> 4) & 15));
    LAS unsigned char* vst = lds + (tid >> 4) * 256 + 16 * ((tid & 15) ^ (2 * ((tid >> 4) & 7)));
    __syncthreads();
    int u = vcu;
    if (u < nunits) {
        AUnit a = attn_decode<PH>(u, half);
        u32x4 st[12];
        attn_issue(st, Kb, a, tid);
        for (;;) {
            const int dsh = 2 * a.g, np = a.np, g = a.g, h = a.h;
            bf16x8 qf[2][4];
#pragma unroll
            for (int s2 = 0; s2 < 2; ++s2) { const int sq0 = ((((2 * np + hh) * 128 + 32 * jq + 16 * s2 + ln)) << dsh) + a.r; const bf16_t* qp0 = Qb + ((size_t)((g * 4 + a.b) * NH + h) * SEQ + sq0) * 128;
#pragma unroll
                for (int c = 0; c < 4; ++c) qf[s2][c] = *(const bf16x8*)(qp0 + 32 * c + 8 * q); }
#pragma unroll
            for (int it = 0; it < 12; ++it) *(LAS u32x4*)(kst + it * 8192) = st[it];
            AT_RAWBAR();
            attn_issue(st, Vb, a, tid);
            const int un = u + G; const bool has_next = un < nunits; AUnit an = a;
            if (has_next) an = attn_decode<PH>(un, half);
            f32x4 s0[10], s1[10];
            { bf16x8 kf[2][4];
#define AT_LOADK(buf, jt_) do { _Pragma("unroll") for (int c = 0; c < 4; ++c) kf[buf][c] = *(const LAS bf16x8*)(kb4[c] + 4096 * (jt_)); } while (0)
              AT_LOADK(0, 0);
#pragma unroll
              for (int jt = 0; jt < 10; ++jt) {
                  if (jt + 1 < 10) AT_LOADK((jt + 1) & 1, jt + 1);
                  __builtin_amdgcn_sched_barrier(0);
                  if (jt < 9) { f32x4 acc = (f32x4){0.f, 0.f, 0.f, 0.f};
#pragma unroll
                      for (int c = 0; c < 4; ++c) acc = __builtin_amdgcn_mfma_f32_16x16x32_bf16(kf[jt & 1][c], qf[0][c], acc, 0, 0, 0);
                      s0[jt] = acc; }
                  if (jt > 0) { f32x4 acc = (f32x4){0.f, 0.f, 0.f, 0.f};
#pragma unroll
                      for (int c = 0; c < 4; ++c) acc = __builtin_amdgcn_mfma_f32_16x16x32_bf16(kf[jt & 1][c], qf[1][c], acc, 0, 0, 0);
                      s1[jt] = acc; }
                  __builtin_amdgcn_sched_barrier(0);
              }
#undef AT_LOADK
            }
            s0[9] = (f32x4){0.f, 0.f, 0.f, 0.f}; s1[0] = (f32x4){0.f, 0.f, 0.f, 0.f};
            float mx0 = -1e30f, mx1 = -1e30f;
#pragma unroll
            for (int jt = 0; jt < 10; ++jt) { const bool tv = (np > 0) || (T0 + jt >= 8);
#pragma unroll
                for (int j = 0; j < 4; ++j) {
                    if (jt < 9) { bool ok = tv; if (jt == 0) ok = ok && (e0 + j >= 0); if (jt == 8) ok = ok && (e0 + j <= 0); const float v = ok ? s0[jt][j] : -1e30f; s0[jt][j] = v; mx0 = fmaxf(mx0, v); }
                    if (jt > 0) { bool ok = tv; if (jt == 1) ok = ok && (e0 + j >= 0); if (jt == 9) ok = ok && (e0 + j <= 0); const float v = ok ? s1[jt][j] : -1e30f; s1[jt][j] = v; mx1 = fmaxf(mx1, v); } } }
            mx0 = fmaxf(mx0, __shfl_xor(mx0, 16)); mx0 = fmaxf(mx0, __shfl_xor(mx0, 32)); mx1 = fmaxf(mx1, __shfl_xor(mx1, 16)); mx1 = fmaxf(mx1, __shfl_xor(mx1, 32));
            float l0 = 0.f, l1 = 0.f;
#pragma unroll
            for (int jt = 0; jt < 10; ++jt)
#pragma unroll
                for (int j = 0; j < 4; ++j) { if (jt < 9) { const float pv = __builtin_amdgcn_exp2f(s0[jt][j] - mx0); s0[jt][j] = pv; l0 += pv; } if (jt > 0) { const float pv = __builtin_amdgcn_exp2f(s1[jt][j] - mx1); s1[jt][j] = pv; l1 += pv; } }
            l0 += __shfl_xor(l0, 16); l0 += __shfl_xor(l0, 32); l1 += __shfl_xor(l1, 16); l1 += __shfl_xor(l1, 32);
            u32x4 pb0[5], pb1[5];
#pragma unroll
            for (int ch = 0; ch < 5; ++ch) { pb0[ch].x = cvt_pk_bf16(s0[2 * ch][0], s0[2 * ch][1]); pb0[ch].y = cvt_pk_bf16(s0[2 * ch][2], s0[2 * ch][3]); pb0[ch].z = cvt_pk_bf16(s0[2 * ch + 1][0], s0[2 * ch + 1][1]); pb0[ch].w = cvt_pk_bf16(s0[2 * ch + 1][2], s0[2 * ch + 1][3]);
                pb1[ch].x = cvt_pk_bf16(s1[2 * ch][0], s1[2 * ch][1]); pb1[ch].y = cvt_pk_bf16(s1[2 * ch][2], s1[2 * ch][3]); pb1[ch].z = cvt_pk_bf16(s1[2 * ch + 1][0], s1[2 * ch + 1][1]); pb1[ch].w = cvt_pk_bf16(s1[2 * ch + 1][2], s1[2 * ch + 1][3]); }
            AT_RAWBAR();
#pragma unroll
            for (int it = 0; it < 12; ++it) *(LAS u32x4*)(vst + it * 8192) = st[it];
            AT_RAWBAR();
            if (has_next) attn_issue(st, Kb, an, tid);
            f32x4 o0[8], o1[8];
#pragma unroll
            for (int db = 0; db < 8; ++db) { o0[db] = (f32x4){0.f, 0.f, 0.f, 0.f}; o1[db] = (f32x4){0.f, 0.f, 0.f, 0.f}; }
            { s16x4 lo[2][4], hi[2][4];
#define AT_TRISSUE(buf, st_) do { _Pragma("unroll") for (int d4 = 0; d4 < 4; ++d4) { lo[buf][d4] = tr_read_o<4096 * (2 * ((st_) >> 1))>(vb8[4 * ((st_) & 1) + d4]); hi[buf][d4] = tr_read_o<4096 * (2 * ((st_) >> 1) + 1)>(vb8[4 * ((st_) & 1) + d4]); } } while (0)
#define AT_PVSTEP(st_) do { \
                  if ((st_) + 1 < 10) { AT_TRISSUE(((st_) + 1) & 1, ((st_) + 1 < 10 ? (st_) + 1 : 9)); asm volatile("s_waitcnt lgkmcnt(8)" ::: "memory"); } \
                  else asm volatile("s_waitcnt lgkmcnt(0)" ::: "memory"); \
                  __builtin_amdgcn_sched_barrier(0); \
                  { union { u32x4 uu; bf16x8 v; } pa, pc; pa.uu = pb0[(st_) >> 1]; pc.uu = pb1[(st_) >> 1]; \
                    _Pragma("unroll") for (int d4 = 0; d4 < 4; ++d4) { const bf16x8 vf = (bf16x8){lo[(st_) & 1][d4][0], lo[(st_) & 1][d4][1], lo[(st_) & 1][d4][2], lo[(st_) & 1][d4][3], hi[(st_) & 1][d4][0], hi[(st_) & 1][d4][1], hi[(st_) & 1][d4][2], hi[(st_) & 1][d4][3]}; \
                      o0[4 * ((st_) & 1) + d4] = __builtin_amdgcn_mfma_f32_16x16x32_bf16(vf, pa.v, o0[4 * ((st_) & 1) + d4], 0, 0, 0); \
                      o1[4 * ((st_) & 1) + d4] = __builtin_amdgcn_mfma_f32_16x16x32_bf16(vf, pc.v, o1[4 * ((st_) & 1) + d4], 0, 0, 0); } } \
                  __builtin_amdgcn_sched_barrier(0); } while (0)
              AT_TRISSUE(0, 0);
              AT_PVSTEP(0); AT_PVSTEP(1); AT_PVSTEP(2); AT_PVSTEP(3); AT_PVSTEP(4); AT_PVSTEP(5); AT_PVSTEP(6); AT_PVSTEP(7); AT_PVSTEP(8); AT_PVSTEP(9);
#undef AT_PVSTEP
#undef AT_TRISSUE
            }
            AT_RAWBAR();
#pragma unroll
            for (int s2 = 0; s2 < 2; ++s2) {
                const int sq = ((((2 * np + hh) * 128 + 32 * jq + 16 * s2 + ln)) << dsh) + a.r; const size_t qrow = (size_t)(a.b * SEQ + sq);
                bf16_t* qp = Qb + ((size_t)((g * 4 + a.b) * NH + h) * SEQ + sq) * 128;
                const float l = s2 ? l1 : l0, mx = s2 ? mx1 : mx0; const f32x4 (&o)[8] = s2 ? o1 : o0;
                const float invl = 1.0f / l, L = mx + __builtin_amdgcn_logf(l);
                if (PH == 0) {
#pragma unroll
                    for (int db = 0; db < 8; ++db) { u32x2 wv; wv.x = cvt_pk_bf16(o[db][0] * invl, o[db][1] * invl); wv.y = cvt_pk_bf16(o[db][2] * invl, o[db][3] * invl); *(u32x2*)(qp + 16 * db + 4 * q) = wv; }
                    if (q == 0) lse[(size_t)(g - 1) * T * NH + qrow * NH + h] = L;
                } else {
                    bf16_t* gp = sg + qrow * D + h * 128; const bf16_t* q1 = qp + (size_t)4 * NH * SEQ * 128; const bf16_t* q2 = qp + (size_t)8 * NH * SEQ * 128;
                    const float L1 = lse[qrow * NH + h], L2 = lse[(size_t)T * NH + qrow * NH + h];
                    u32x2 a1[8], a2[8], gg[8];
#pragma unroll
                    for (int db = 0; db < 8; ++db) { a1[db] = *(const u32x2*)(q1 + 16 * db + 4 * q); a2[db] = *(const u32x2*)(q2 + 16 * db + 4 * q); gg[db] = *(const u32x2*)(gp + 16 * db + 4 * q); }
                    const float Lm = fmaxf(L, fmaxf(L1, L2));
                    const float x0 = __builtin_amdgcn_exp2f(L - Lm), x1 = __builtin_amdgcn_exp2f(L1 - Lm), x2 = __builtin_amdgcn_exp2f(L2 - Lm); const float inv = 1.0f / (x0 + x1 + x2);
                    const float w0 = x0 * inv * invl, w1 = x1 * inv, w2 = x2 * inv;
#pragma unroll
                    for (int db = 0; db < 8; ++db) {
                        const float r0 = (w0 * o[db][0] + w1 * bf_lo(a1[db].x) + w2 * bf_lo(a2[db].x)) * bf_lo(gg[db].x), r1 = (w0 * o[db][1] + w1 * bf_hi(a1[db].x) + w2 * bf_hi(a2[db].x)) * bf_hi(gg[db].x);
                        const float r2 = (w0 * o[db][2] + w1 * bf_lo(a1[db].y) + w2 * bf_lo(a2[db].y)) * bf_lo(gg[db].y), r3 = (w0 * o[db][3] + w1 * bf_hi(a1[db].y) + w2 * bf_hi(a2[db].y)) * bf_hi(gg[db].y);
                        u32x2 wv; wv.x = cvt_pk_bf16(r0, r1); wv.y = cvt_pk_bf16(r2, r3); *(u32x2*)(gp + 16 * db + 4 * q) = wv; }
                }
            }
            if (!has_next) break;
            u = un; a = an;
        }
    }
    __syncthreads();
}

#define XB_TMO      128
#define XB_XCNT(j)  (256  + 64 * (j))
#define XB_XSUB(j)  (1280 + 64 * (j))
#define XB_XGEN(j)  (2304 + 64 * (j))
#define XB_TOP      3328
#define XB_TOPGEN   3392
#define XCD_BAR_WORDS 3456
#define XB_SPIN_CAP (1u << 18)

__device__ __forceinline__ unsigned xb_ld(unsigned* p)              { return __hip_atomic_load(p, __ATOMIC_RELAXED, __HIP_MEMORY_SCOPE_AGENT); }
__device__ __forceinline__ unsigned xb_add(unsigned* p, unsigned v) { return __hip_atomic_fetch_add(p, v, __ATOMIC_RELAXED, __HIP_MEMORY_SCOPE_AGENT); }
__device__ __forceinline__ unsigned xb_xcc_id() { return (unsigned)__builtin_amdgcn_s_getreg((3 << 11) | 20) & 0xFu; }
#define XB_SPIN(cond, bar) do { unsigned _sp = 0; while (cond) { __builtin_amdgcn_s_sleep(1); \
    if ((++_sp & 255u) == 0u) { if (xb_ld(&(bar)[XB_TMO])) break; if (_sp > XB_SPIN_CAP) { atomicAdd(&(bar)[XB_TMO], 1u); break; } } } } while (0)

struct XcdBarrier {
    unsigned gsz;
    unsigned* bar; unsigned x;
    volatile LAS unsigned* st;
};

__device__ __forceinline__ XcdBarrier xcd_barrier_post(unsigned* bar, volatile LAS unsigned* st, unsigned gsz) {
    XcdBarrier b; b.gsz = gsz; b.bar = bar; b.x = xb_xcc_id(); b.st = st;
    if (threadIdx.x == 0) (void)xb_add(&bar[XB_XCNT(b.x)], 1u);
    return b;
}
__device__ __forceinline__ void xcd_barrier_complete(unsigned* bar, unsigned x, unsigned& nloc, unsigned& nx, unsigned G) {
    unsigned sum, cnt, mine, sp = 0u;
    for (;;) {
        sum = 0u; cnt = 0u; mine = 0u;
#pragma unroll
        for (unsigned j = 0; j < 16; ++j) { const unsigned c = xb_ld(&bar[XB_XCNT(j)]); sum += c; cnt += (c > 0u) ? 1u : 0u; mine = (j == x) ? c : mine; }
        if (sum == G) break;
        __builtin_amdgcn_s_sleep(1);
        if ((++sp & 255u) == 0u) { if (xb_ld(&bar[XB_TMO])) break; if (sp > XB_SPIN_CAP) { atomicAdd(&bar[XB_TMO], 1u); break; } }
    }
    nloc = mine > 0u ? mine : 1u; nx = cnt > 0u ? cnt : 1u;
}

__device__ __forceinline__ void xcd_barrier(const XcdBarrier& b) {
    asm volatile("s_waitcnt vmcnt(0)" ::: "memory");
    __syncthreads();
    if (threadIdx.x == 0) {
        unsigned* bar = b.bar;
        __builtin_amdgcn_s_waitcnt(0);
        unsigned nloc = b.st[0], nx = b.st[1];
        if (nloc == 0u) { xcd_barrier_complete(bar, b.x, nloc, nx, b.gsz); b.st[0] = nloc; b.st[1] = nx; }
        const unsigned old = xb_add(&bar[XB_XSUB(b.x)], 1u);
        const unsigned gen = old / nloc;
        if (old + 1u == (gen + 1u) * nloc) {
            __builtin_amdgcn_fence(__ATOMIC_RELEASE, "agent");
            asm volatile("s_waitcnt vmcnt(0)" ::: "memory");
            const unsigned og = xb_add(&bar[XB_TOP], 1u);
            const unsigned tg = og / nx;
            if (og + 1u == (tg + 1u) * nx) xb_add(&bar[XB_TOPGEN], 1u);
            else XB_SPIN(xb_ld(&bar[XB_TOPGEN]) == tg, bar);
            __builtin_amdgcn_fence(__ATOMIC_ACQUIRE, "agent");
            xb_add(&bar[XB_XGEN(b.x)], 1u);
            asm volatile("s_waitcnt vmcnt(0)" ::: "memory");
        } else {
            XB_SPIN(xb_ld(&bar[XB_XGEN(b.x)]) == gen, bar);
            __builtin_amdgcn_fence(__ATOMIC_ACQUIRE, "agent");
            asm volatile("s_waitcnt vmcnt(0)" ::: "memory");
        }
    }
    __syncthreads();
}

__device__ __forceinline__ void flag_set(unsigned* f) { __hip_atomic_store(f, 1u, __ATOMIC_RELEASE, __HIP_MEMORY_SCOPE_AGENT); }
__device__ __forceinline__ void flag_wait(unsigned* f) {
    if (threadIdx.x == 0) { unsigned sp = 0u;
        while (__hip_atomic_load(f, __ATOMIC_RELAXED, __HIP_MEMORY_SCOPE_AGENT) == 0u) { __builtin_amdgcn_s_sleep(4); if (++sp > (1u << 22)) break; }
        __builtin_amdgcn_fence(__ATOMIC_ACQUIRE, "agent"); asm volatile("s_waitcnt vmcnt(0)" ::: "memory"); }
    __syncthreads();
}
__global__ void __launch_bounds__(512, 2) mega(Params p) {
    extern __shared__ __attribute__((aligned(16))) unsigned char lds_raw[];
    LAS unsigned char* lds = (LAS unsigned char*)lds_raw;
    cg::grid_group grid = cg::this_grid();
    const int G = gridDim.x, bx = blockIdx.x; const int vcu = (bx % 8) * (G / 8) + bx / 8;
    const int half = (bx % 8) >> 2, LG = G / 2, xq = bx % 4, idx = bx / 8;
    const int lv = xq * (G / 8) + idx;
    const int cl = 8 * (idx >> 1) + 2 * xq + (idx & 1);
    unsigned char* ws = p.ws; unsigned char* ow = (unsigned char*)p.out;
    float* ssq = (float*)(ws + WS_SSQ); float* lse = (float*)(ws + WS_LSE); const float* cosT = (const float*)(ws + WS_COS); const float* sinT = (const float*)(ws + WS_SIN);
    bf16_t* Kb = (bf16_t*)(ws + WS_K); bf16_t* Vb = (bf16_t*)(ws + WS_V); bf16_t* Qb = (bf16_t*)(ws + WS_Q);
    unsigned* flagB = (unsigned*)(ws + WS_FLAGS); unsigned* flagA = flagB + 64; unsigned* flagD = flagB + 128;
    if (threadIdx.x == 0) { volatile LAS unsigned* st = (volatile LAS unsigned*)(lds + LDS_BARST); st[0] = 0u; st[1] = 0u; st[2] = 0u; st[3] = 0u; }
    __syncthreads();
    XcdBarrier gbar = xcd_barrier_post((unsigned*)(ws + WS_BAR), (volatile LAS unsigned*)(lds + LDS_BARST), (unsigned)G);
    XcdBarrier hbar = xcd_barrier_post((unsigned*)(ws + WS_BAR) + 4096 * (1 + half), (volatile LAS unsigned*)(lds + LDS_BARST + 8), (unsigned)LG);
#define SEAM() xcd_barrier(hbar)
    prologue(p, lds, vcu, G); __syncthreads();
    xcd_barrier(gbar);
    unsigned* flagF = flagB + 192;
    if (half == 0) {
        pg8::Gemm g{(const bf16_t*)(ow + WS_WG0), (const bf16_t*)(ws + WS_WU), 2 * D, D, 512, 512, 0, D, 1}; pg8::StaticOrder S; S.init(2 * D, D, LG, cl);
        EpiFold E{(bf16_t*)(ow + WS_WINA0), (size_t)(WS_WINA1 - WS_WINA0) / 2}; pg8::gemm_phase<EpiFold, pg8::StaticOrder, true, true>(lds, g, S, E); SEAM();
        if (lv == 0 && threadIdx.x == 0) flag_set(flagF);
    } else {
        convert_bweights(p, lds, lv, LG); __syncthreads(); SEAM(); if (lv == 0 && threadIdx.x == 0) flag_set(flagB);
        flag_wait(flagF);
    }
#pragma unroll 1
    for (int layer = 0; layer < 2; ++layer) {
        bf16_t* xb_in = (bf16_t*)(ws + ((layer & 1) ? WS_BUF1 : WS_BUF0)); bf16_t* other = (bf16_t*)(ws + ((layer & 1) ? WS_BUF0 : WS_BUF1));
        bf16_t* zb = Kb; bf16_t* hb = Qb;
        { pg8::Gemm g{xb_in, (const bf16_t*)(ow + (layer ? WS_WINA1 : WS_WINA0)), T / 2, 2 * D, D, D, 0, D, 0}; pg8::HalfOrder S; S.init(T / 2, 2 * D, LG, cl); S.pmoff = 32 * half;
          EpiInA E{ssq + layer * T, zb, other};
          pg8::gemm_phase<EpiInA, pg8::HalfOrder, true, true>(lds, g, S, E); SEAM(); }
        { pool_phase(zb, other, p.in[4] + layer * D, hb, lv, LG, half); SEAM(); }
        { pg8::Gemm g{hb, (const bf16_t*)(ow + (layer ? WS_WOUTA1 : WS_WOUTA0)), T / 2, D, D, D, 0, D, 0}; pg8::HalfOrder S; S.init(T / 2, D, LG, cl); S.pmoff = 32 * half;
          EpiOut E{xb_in, other, ssq + (layer + 1) * T};
          pg8::gemm_phase<EpiOut, pg8::HalfOrder, true, true>(lds, g, S, E); SEAM(); }
    }
    if (half == 1) { if (lv == 0 && threadIdx.x == 0) flag_set(flagA); }
    else flag_wait(flagB);
#pragma unroll 1
    for (int lb = 0; lb < 2; ++lb) {
        const int layer = 2 + lb;
        bf16_t* xb_in = (bf16_t*)(ws + WS_BUF0); bf16_t* other = (bf16_t*)(ws + WS_BUF1);
        { const int N = lb == 0 ? 6 * D : 4 * D; pg8::Gemm g{xb_in, lb == 0 ? (const bf16_t*)(ws + WS_SLOTA) : (const bf16_t*)(ow + OUT_WINB1), T / 2, N, D, D, 0, D, 0}; pg8::HalfOrder S; S.init(T / 2, N, LG, cl); S.pmoff = 32 * half;
          EpiInB E{ssq + layer * T, cosT, sinT, Kb, Vb, Qb, other, lb == 0 ? 16 : 0};
          pg8::gemm_phase<EpiInB, pg8::HalfOrder, true, true>(lds, g, S, E); SEAM(); }
        { attn_phase<0>(lds, Kb, Vb, Qb, other, lse, lv, LG, half); SEAM(); }
        { attn_phase<1>(lds, Kb, Vb, Qb, other, lse, lv, LG, half); SEAM(); }
        { pg8::Gemm g{other, lb == 0 ? (const bf16_t*)(ws + WS_WOUTB0) : (const bf16_t*)(ow + OUT_WOUTB1), T / 2, D, D, D, 0, D, 0}; pg8::HalfOrder S; S.init(T / 2, D, LG, cl); S.pmoff = 32 * half;
          EpiOut E{xb_in, xb_in, ssq + (layer + 1) * T}; pg8::gemm_phase<EpiOut, pg8::HalfOrder, true, true>(lds, g, S, E); SEAM(); }
    }
    if (half == 0) { if (lv == 0 && threadIdx.x == 0) flag_set(flagD); flag_wait(flagA); }
    else flag_wait(flagD);
    final_norm((const bf16_t*)(ws + WS_BUF0), p.out, ssq + 4 * T, p.in[12], lv, LG, half);
    if (p.ph_hi == 12345) grid.sync();
#undef SEAM
}

extern "C" void kernel_launch(void* const* d_in, const int* in_sizes, int n_in, void* d_out, int out_size, void* d_ws, size_t ws_size, hipStream_t stream) {
    static int grid = 0;
    if (grid == 0) {
        if (n_in != 13 || out_size != T * D || ws_size < WS_END) { fprintf(stderr, "kernel_launch: unexpected shapes (n_in %d out %d ws %zu); nothing launched\n", n_in, out_size, ws_size); grid = -1; return; }
        int dev = 0, cus = 0, per_cu = 0;
        if (hipGetDevice(&dev) != hipSuccess || hipDeviceGetAttribute(&cus, hipDeviceAttributeMultiprocessorCount, dev) != hipSuccess) { grid = -1; return; }
        if (hipFuncSetAttribute((const void*)mega, hipFuncAttributeMaxDynamicSharedMemorySize, LDS_BYTES) != hipSuccess) { fprintf(stderr, "kernel_launch: hipFuncSetAttribute failed\n"); grid = -1; return; }
        if (hipOccupancyMaxActiveBlocksPerMultiprocessor(&per_cu, (const void*)mega, 512, LDS_BYTES) != hipSuccess || per_cu < 1) { fprintf(stderr, "kernel_launch: occupancy query gave %d\n", per_cu); per_cu = 1; }
        (void)hipGetLastError();
        grid = cus * per_cu;
        if (grid % 16 != 0) { fprintf(stderr, "kernel_launch: the two half-grids need a workgroup count that is a multiple of 16 (got %d); nothing launched\n", grid); grid = -1; return; }
    }
    if (grid < 0) return;
    Params p{};
    for (int i = 0; i < 13; ++i) p.in[i] = (const float*)d_in[i];
    p.out = (float*)d_out; p.ws = (unsigned char*)d_ws; p.ph_lo = 0; p.ph_hi = 1;
    if (hipMemsetAsync((unsigned char*)d_ws + WS_BAR, 0, (3 * 4096 + 256) * 4, stream) != hipSuccess) { fprintf(stderr, "kernel_launch: hipMemsetAsync failed; nothing launched\n"); return; }
    void* args[] = {&p};
    hipError_t e = hipLaunchCooperativeKernel((const void*)mega, dim3(grid), dim3(512), args, LDS_BYTES, stream);
    if (e != hipSuccess) fprintf(stderr, "kernel_launch: cooperative launch failed: %s (grid %d)\n", hipGetErrorString(e), grid);
}
```
